# Optimizing an MI355X kernel written in HIP

```python
import jax, jax.numpy as jnp
from jax import lax
import numpy as np

D_MODEL = 2048
BATCH = 8
SEQ = 2048
DEPTH = 2

HEAD_DIM = 128
ATTN_WIDTH = D_MODEL // 2
CONV_DIM = D_MODEL - ATTN_WIDTH
MIX_DIM = ATTN_WIDTH + CONV_DIM
N_Q_HEADS = ATTN_WIDTH // HEAD_DIM
N_KV_HEADS = max(1, N_Q_HEADS // 4)
Q_PER_KV = N_Q_HEADS // N_KV_HEADS
Q_DIM = N_Q_HEADS * HEAD_DIM
KV_DIM = N_KV_HEADS * HEAD_DIM
N_CONV_GROUPS = CONV_DIM // HEAD_DIM
CONV_WIDTH = 3
IN_PROJ_DIM = Q_DIM + 2 * KV_DIM + 3 * CONV_DIM
DILATED_BRANCHES = ((128, 1), (512, 4), (2048, 16))
D_FF = 5632
FFN_RESIDUAL_WEIGHT = 0.5
NORM_EPS = 1e-6

kernel_name = 'hybrid_dilated_attn_shortconv_macaron'


def rms_norm(x, gain):
    xf = x.astype(jnp.float32)
    y = xf * lax.rsqrt(jnp.mean(xf * xf, axis=-1, keepdims=True) + NORM_EPS)
    return (y * gain.astype(jnp.float32)).astype(x.dtype)


def swiglu(x, w_gate_up, w_down):
    gu = x @ w_gate_up
    gate, up = jnp.split(gu, 2, axis=-1)
    return (jax.nn.silu(gate) * up) @ w_down


def dilated_branch(q, k, v, window, dilation):
    b, s, g, r, hd = q.shape
    span = window // dilation
    blk = span
    sub_len = -(-s // dilation)
    nb = -(-sub_len // blk)
    sp = nb * blk * dilation
    pad = sp - s
    qb = jnp.pad(q, ((0, 0), (0, pad), (0, 0), (0, 0), (0, 0))).reshape(b, nb, blk, dilation, g, r, hd)
    kb = jnp.pad(k, ((0, 0), (0, pad), (0, 0), (0, 0))).reshape(b, nb, blk, dilation, g, hd)
    vb = jnp.pad(v, ((0, 0), (0, pad), (0, 0), (0, 0))).reshape(b, nb, blk, dilation, g, hd)

    def with_prev(t):
        prev = jnp.pad(t[:, :-1], ((0, 0), (1, 0), (0, 0), (0, 0), (0, 0), (0, 0)))
        return jnp.concatenate([prev, t], axis=2)

    kw = with_prev(kb)
    vw = with_prev(vb)
    scores = jnp.einsum('bnqeghd,bnkegd->bneghqk', qb, kw,
                        preferred_element_type=jnp.float32) * (hd ** -0.5)
    qi = jnp.arange(blk)[:, None]
    kj = jnp.arange(2 * blk)[None, :]
    dist = qi - kj + blk
    band = (dist >= 0) & (dist <= span)
    valid = band[None] & ((jnp.arange(nb)[:, None, None] > 0) | (kj[None] >= blk))
    scores = jnp.where(valid[None, :, None, None, None], scores, -jnp.inf)
    m = jnp.max(scores, axis=-1, keepdims=True)
    p = jnp.exp(scores - m)
    den = jnp.sum(p, axis=-1, keepdims=True)
    o = jnp.einsum('bneghqk,bnkegd->bnqeghd', p / den, vw.astype(jnp.float32))
    lse = jnp.moveaxis((m + jnp.log(den))[..., 0], -1, 2)
    o = o.reshape(b, sp, g, r, hd)[:, :s]
    lse = lse.reshape(b, sp, g, r)[:, :s]
    return o, lse


def dilated_attention(q, k, v):
    b, s, _ = q.shape
    qh = q.reshape(b, s, N_KV_HEADS, Q_PER_KV, HEAD_DIM)
    kh = k.reshape(b, s, N_KV_HEADS, HEAD_DIM)
    vh = v.reshape(b, s, N_KV_HEADS, HEAD_DIM)
    outs, lses = [], []
    for window, dilation in DILATED_BRANCHES:
        o, lse = dilated_branch(qh, kh, vh, window, dilation)
        outs.append(o)
        lses.append(lse)
    weights = jax.nn.softmax(jnp.stack(lses, axis=0), axis=0)
    o = jnp.sum(weights[..., None] * jnp.stack(outs, axis=0), axis=0)
    return o.reshape(b, s, Q_DIM).astype(q.dtype)


def gated_short_conv(h, b_gate, c_gate, conv_w):
    u = c_gate * h
    y = lax.conv_general_dilated(
        u, conv_w[:, None, :].astype(u.dtype), window_strides=(1,),
        padding=[(CONV_WIDTH - 1, 0)], dimension_numbers=('NWC', 'WIO', 'NWC'),
        feature_group_count=u.shape[-1])
    return b_gate * y


def setup_inputs(seed: int = 0) -> dict:
    key = jax.random.key(seed)
    ks = jax.random.split(key, 20)

    def w(k, shape, fan_in):
        return jax.random.normal(k, shape, jnp.float32) * (fan_in ** -0.5)

    def gain(k, shape):
        return 1.0 + 0.02 * jax.random.normal(k, shape, jnp.float32)

    return {
        'x': jax.random.normal(ks[0], (BATCH, SEQ, D_MODEL), jnp.float32),
        'ffn1_norm_pre': gain(ks[1], (DEPTH, D_MODEL)),
        'ffn1_w_gate_up': w(ks[2], (DEPTH, D_MODEL, 2 * D_FF), D_MODEL),
        'ffn1_w_down': w(ks[3], (DEPTH, D_FF, D_MODEL), D_FF),
        'ffn1_norm_post': gain(ks[4], (DEPTH, D_MODEL)),
        'mix_norm_pre': gain(ks[5], (DEPTH, D_MODEL)),
        'w_in': w(ks[6], (DEPTH, D_MODEL, IN_PROJ_DIM), D_MODEL),
        'conv_w': w(ks[7], (DEPTH, CONV_WIDTH, CONV_DIM), CONV_WIDTH),
        'attn_out_norm': gain(ks[8], (DEPTH, Q_DIM)),
        'conv_out_norm': gain(ks[9], (DEPTH, CONV_DIM)),
        'w_out': w(ks[10], (DEPTH, MIX_DIM, D_MODEL), MIX_DIM),
        'mix_norm_post': gain(ks[11], (DEPTH, D_MODEL)),
        'ffn2_norm_pre': gain(ks[12], (DEPTH, D_MODEL)),
        'ffn2_w_gate_up': w(ks[13], (DEPTH, D_MODEL, 2 * D_FF), D_MODEL),
        'ffn2_w_down': w(ks[14], (DEPTH, D_FF, D_MODEL), D_FF),
        'ffn2_norm_post': gain(ks[15], (DEPTH, D_MODEL)),
    }


def reference(x, ffn1_norm_pre, ffn1_w_gate_up, ffn1_w_down, ffn1_norm_post,
              mix_norm_pre, w_in, conv_w, attn_out_norm, conv_out_norm, w_out,
              mix_norm_post, ffn2_norm_pre, ffn2_w_gate_up, ffn2_w_down,
              ffn2_norm_post):
    split_at = [Q_DIM, Q_DIM + KV_DIM, Q_DIM + 2 * KV_DIM,
                Q_DIM + 2 * KV_DIM + CONV_DIM, Q_DIM + 2 * KV_DIM + 2 * CONV_DIM]
    for l in range(DEPTH):
        h = swiglu(rms_norm(x, ffn1_norm_pre[l]), ffn1_w_gate_up[l], ffn1_w_down[l])
        x = x + FFN_RESIDUAL_WEIGHT * rms_norm(h, ffn1_norm_post[l])
        h = rms_norm(x, mix_norm_pre[l])
        z = h @ w_in[l]
        q, k, v, hc, b_gate, c_gate = jnp.split(z, split_at, axis=-1)
        a = dilated_attention(q, k, v)
        c = gated_short_conv(hc, b_gate, c_gate, conv_w[l])
        mixed = jnp.concatenate([rms_norm(a, attn_out_norm[l]),
                                 rms_norm(c, conv_out_norm[l])], axis=-1) @ w_out[l]
        x = x + rms_norm(mixed, mix_norm_post[l])
        h = swiglu(rms_norm(x, ffn2_norm_pre[l]), ffn2_w_gate_up[l], ffn2_w_down[l])
        x = x + FFN_RESIDUAL_WEIGHT * rms_norm(h, ffn2_norm_post[l])
    return x
```

```cpp
#include <hip/hip_runtime.h>
#include <hip/hip_cooperative_groups.h>
#include <cstdio>
#include <cstdint>
namespace pg8 {
#define PG8_LAS __attribute__((address_space(3)))
typedef unsigned short bf16_t;
typedef short bf16x8 __attribute__((ext_vector_type(8)));
typedef float f32x4 __attribute__((ext_vector_type(4)));
typedef unsigned u32x4 __attribute__((ext_vector_type(4)));
constexpr int BM = 256, BK = 64, HALF = 128, HTB = HALF * BK * 2  , STAGE_BYTES = 8 * HTB, NXCD = 8, WGM = 8;

__host__ __device__ __forceinline__ int lds_byte(int r, int c) { const int st = (r >> 4) * 2 + (c >> 5), rr = r & 15, cc = c & 31, ob = rr * 64 + cc * 2; return st * 1024 + (ob ^ (((ob >> 9) & 1) << 5)); }
__host__ __device__ __forceinline__ void stage_rc(int b, int& R, int& C) { const int st = b / 1024, sb = b % 1024, swz = sb ^ (((sb >> 9) & 1) << 5); R = (st >> 1) * 16 + swz / 64; C = (st & 1) * 32 + (swz % 64) / 2; }
__host__ __device__ __forceinline__ int perm32(int rho) { const int n = rho >> 4, i = rho & 15; return 8 * (i >> 2) + 4 * n + (i & 3); }

struct Unit { int pm, pn; };
struct Gemm { const bf16_t* A; const bf16_t* Bt; int M, N, K; };

struct StaticOrder {
    int nM, nN, nwg, G, c;
    __host__ __device__ void init(int M, int N, int G_, int c_) { nM = M / BM; nN = N / BM; nwg = nM * nN; G = G_; c = c_; }
    __host__ __device__ bool next(int i, Unit& u) const {
        const long L = (long)i * G + c; if (L >= nwg) return false;
        int wgid = (int)L; { const int q = nwg / NXCD, r = nwg % NXCD, xcd = wgid % NXCD, off = wgid / NXCD; wgid = (xcd < r ? xcd * (q + 1) : r * (q + 1) + (xcd - r) * q) + off; }
        const int nig = WGM * nN, gid = wgid / nig, fm = gid * WGM, gsz = (nM - fm) < WGM ? (nM - fm) : WGM;
        u.pm = fm + ((wgid % nig) % gsz); u.pn = (wgid % nig) / gsz; return true;
    }
    __device__ __forceinline__ void a_ready(const Unit&) const {}
    __device__ __forceinline__ void done(const Unit&) const {}
};
__device__ __forceinline__ unsigned cvt_pk_bf16(float lo, float hi) { unsigned r; asm volatile("v_cvt_pk_bf16_f32 %0, %1, %2" : "=v"(r) : "v"(lo), "v"(hi)); return r; }
struct EpiF32 {
    static constexpr bool PERM = false, AFTER_DRAIN = false;
    float* C; int ldc;
    __device__ __forceinline__ void operator()(const f32x4 (&acc)[2][2][4][2], const Unit& u, int wr, int wc, int fr, int fq) const {
        const int row0 = u.pm * BM + wr * 64 + fr, col0 = u.pn * BM + wc * 32 + 4 * fq;
#pragma unroll
        for (int ai = 0; ai < 2; ++ai)
#pragma unroll
            for (int m = 0; m < 4; ++m) { float* rowp = C + (size_t)(row0 + ai * HALF + m * 16) * ldc + col0;
#pragma unroll
                for (int bj = 0; bj < 2; ++bj)
#pragma unroll
                    for (int n = 0; n < 2; ++n) *(f32x4*)(rowp + bj * HALF + n * 16) = acc[ai][bj][m][n]; }
    }
};
struct EpiBf16 {
    static constexpr bool PERM = true, AFTER_DRAIN = false;
    bf16_t* O; int ldc;
    __device__ __forceinline__ void operator()(const f32x4 (&acc)[2][2][4][2], const Unit& u, int wr, int wc, int fr, int fq) const {
        const int row0 = u.pm * BM + wr * 64 + fr, col0 = u.pn * BM + wc * 32 + 8 * fq;
#pragma unroll
        for (int ai = 0; ai < 2; ++ai)
#pragma unroll
            for (int m = 0; m < 4; ++m) { bf16_t* rowp = O + (size_t)(row0 + ai * HALF + m * 16) * ldc + col0;
#pragma unroll
                for (int bj = 0; bj < 2; ++bj) { const f32x4 v0 = acc[ai][bj][m][0], v1 = acc[ai][bj][m][1];
                    u32x4 w; w.x = cvt_pk_bf16(v0[0], v0[1]); w.y = cvt_pk_bf16(v0[2], v0[3]); w.z = cvt_pk_bf16(v1[0], v1[1]); w.w = cvt_pk_bf16(v1[2], v1[3]);
                    *(u32x4*)(rowp + bj * HALF) = w; } }
    }
};
__device__ __forceinline__ float silu_mul(float g, float u) { return g * u * __builtin_amdgcn_rcpf(1.0f + __builtin_amdgcn_exp2f(g * -1.4426950408889634f)); }
struct EpiSwiGLU {
    static constexpr bool PERM = true, AFTER_DRAIN = false;
    bf16_t* O; int ldc;
    __device__ __forceinline__ void operator()(const f32x4 (&acc)[2][2][4][2], const Unit& u, int wr, int wc, int fr, int fq) const {
        const int row0 = u.pm * BM + wr * 64 + fr, col0 = u.pn * HALF + wc * 32 + 8 * fq;
#pragma unroll
        for (int ai = 0; ai < 2; ++ai)
#pragma unroll
            for (int m = 0; m < 4; ++m) { bf16_t* rowp = O + (size_t)(row0 + ai * HALF + m * 16) * ldc + col0;
                const f32x4 g0 = acc[ai][0][m][0], g1 = acc[ai][0][m][1], u0 = acc[ai][1][m][0], u1 = acc[ai][1][m][1];
                u32x4 w; w.x = cvt_pk_bf16(silu_mul(g0[0], u0[0]), silu_mul(g0[1], u0[1])); w.y = cvt_pk_bf16(silu_mul(g0[2], u0[2]), silu_mul(g0[3], u0[3]));
                w.z = cvt_pk_bf16(silu_mul(g1[0], u1[0]), silu_mul(g1[1], u1[1])); w.w = cvt_pk_bf16(silu_mul(g1[2], u1[2]), silu_mul(g1[3], u1[3]));
                *(u32x4*)rowp = w; }
    }
};

template <class Epi, class Sched, bool ALIGN_EPI = false, bool SP2 = false>
__device__ __forceinline__ void gemm_phase(PG8_LAS unsigned char* lds, const Gemm g, const Sched& S, const Epi& E, int tid_in) {
    int tid_l = tid_in; asm volatile("" : "+v"(tid_l));
    const int tid = tid_l, wid = __builtin_amdgcn_readfirstlane(tid >> 6), lane = tid & 63, wr = wid >> 2, wc = wid & 3, fr = lane & 15, fq = lane >> 4;
    const int K = g.K, nt = K / BK;
    unsigned voffA[2], voffB[2];
#pragma unroll
    for (int i = 0; i < 2; ++i) { int R, C; stage_rc(tid * 16 + i * 8192, R, C); const int Rb = Epi::PERM ? ((R & ~31) + perm32(R & 31)) : R;
        voffA[i] = (unsigned)(R * K + C) * 2u; voffB[i] = (unsigned)(Rb * K + C) * 2u; }
    const size_t kstep = (size_t)(BK * 2);
    const size_t hstep = (size_t)HALF * K * 2;
    const size_t tstep = 2 * hstep;
    const unsigned ldsw = (unsigned)wid * 1024u;
    const int aoff = lds_byte(wr * 64 + fr, fq * 8), boff = lds_byte(wc * 32 + fr, fq * 8);
#define PG8_SA(b, h) (((b) * 2 + (h)) * HTB)
#define PG8_SB(b, h) ((4 + (b) * 2 + (h)) * HTB)
#define PG8_STAGE(bufoff, gbase, voff) do { _Pragma("unroll") for (int _i = 0; _i < 2; ++_i) \
        __builtin_amdgcn_global_load_lds((const unsigned*)((const char*)(gbase) + (voff)[_i]), (PG8_LAS unsigned*)(lds + (bufoff) + ldsw + _i * 8192), 16, 0, 0); } while (0)
#define PG8_LDA(dst, b, h) do { _Pragma("unroll") for (int m = 0; m < 4; ++m) _Pragma("unroll") for (int k = 0; k < 2; ++k) dst[m][k] = *(const PG8_LAS bf16x8*)(lds + PG8_SA(b, h) + aoff + m * 2048 + k * 1024); } while (0)
#define PG8_LDB(dst, b, h) do { _Pragma("unroll") for (int n = 0; n < 2; ++n) _Pragma("unroll") for (int k = 0; k < 2; ++k) dst[n][k] = *(const PG8_LAS bf16x8*)(lds + PG8_SB(b, h) + boff + n * 2048 + k * 1024); } while (0)
#define PG8_MMA(ai, bj, At, Bt) do { __builtin_amdgcn_s_setprio(1); _Pragma("unroll") for (int m = 0; m < 4; ++m) _Pragma("unroll") for (int n = 0; n < 2; ++n) _Pragma("unroll") for (int k = 0; k < 2; ++k) \
        acc[ai][bj][m][n] = __builtin_amdgcn_mfma_f32_16x16x32_bf16(Bt[n][k], At[m][k], acc[ai][bj][m][n], 0, 0, 0); __builtin_amdgcn_s_setprio(0); } while (0)
#define PG8_WAIT_V(n) asm volatile("s_waitcnt vmcnt(" #n ")" ::: "memory")
#define PG8_WAIT_L(n) asm volatile("s_waitcnt lgkmcnt(" #n ")" ::: "memory")
#define PG8_BAR __builtin_amdgcn_s_barrier()
#define PG8_SCHED __builtin_amdgcn_sched_barrier(0)
    Unit cur, nxt; int ui = 0;
    if (!S.next(0, cur)) return;
    f32x4 acc[2][2][4][2];
#pragma unroll
    for (int a = 0; a < 2; ++a)
#pragma unroll
        for (int b = 0; b < 2; ++b)
#pragma unroll
            for (int m = 0; m < 4; ++m)
#pragma unroll
                for (int n = 0; n < 2; ++n) acc[a][b][m][n] = (f32x4){0.f, 0.f, 0.f, 0.f};
    bf16x8 At[4][2], B0[2][2], B1[2][2];
    const char* cA = (const char*)g.A + (size_t)cur.pm * tstep; const char* cB = (const char*)g.Bt + (size_t)cur.pn * tstep;
    S.a_ready(cur);
    if constexpr (SP2) {
        PG8_STAGE(PG8_SB(0, 0), cB, voffB); PG8_STAGE(PG8_SB(0, 1), cB + hstep, voffB); PG8_STAGE(PG8_SA(0, 0), cA, voffA); PG8_STAGE(PG8_SA(0, 1), cA + hstep, voffA);
        if (wr == 1) PG8_BAR;
        PG8_WAIT_V(2); PG8_BAR;
        PG8_STAGE(PG8_SB(1, 0), cB + kstep, voffB); PG8_STAGE(PG8_SA(1, 0), cA + kstep, voffA); PG8_STAGE(PG8_SB(1, 1), cB + hstep + kstep, voffB);
        PG8_WAIT_V(6); PG8_BAR;
    } else {
        PG8_STAGE(PG8_SB(0, 0), cB, voffB); PG8_STAGE(PG8_SA(0, 0), cA, voffA); PG8_STAGE(PG8_SB(0, 1), cB + hstep, voffB); PG8_STAGE(PG8_SA(0, 1), cA + hstep, voffA);
        if (wr == 1) PG8_BAR;
        PG8_WAIT_V(4); PG8_BAR;
        PG8_STAGE(PG8_SB(1, 0), cB + kstep, voffB); PG8_STAGE(PG8_SA(1, 0), cA + kstep, voffA); PG8_STAGE(PG8_SB(1, 1), cB + hstep + kstep, voffB);
        PG8_WAIT_V(6); PG8_BAR;
    }
    for (;;) {
        const bool has_next = S.next(ui + 1, nxt);
        const char* nA = has_next ? (const char*)g.A + (size_t)nxt.pm * tstep : cA; const char* nB = has_next ? (const char*)g.Bt + (size_t)nxt.pn * tstep : cB;
        for (int t = 0; t < nt; t += 2) {
            const bool last = (t == nt - 2);
            const char* a1 = cA + (size_t)(t + 1) * kstep;
            const char* a2 = last ? nA : cA + (size_t)(t + 2) * kstep; const char* b2 = last ? nB : cB + (size_t)(t + 2) * kstep;
            const char* a3 = a2 + kstep; const char* b3 = b2 + kstep;
            if (last && has_next) S.a_ready(nxt);
            if constexpr (SP2) {
            PG8_LDB(B0, 0, 0); PG8_LDB(B1, 0, 1); PG8_SCHED; PG8_LDA(At, 0, 0); PG8_STAGE(PG8_SA(1, 1), a1 + hstep, voffA);
            PG8_WAIT_V(8); PG8_WAIT_L(0); PG8_BAR; PG8_MMA(0, 0, At, B0); PG8_MMA(0, 1, At, B1); PG8_BAR; PG8_SCHED;
            PG8_LDA(At, 0, 1); PG8_STAGE(PG8_SB(0, 0), b2, voffB); PG8_STAGE(PG8_SB(0, 1), b2 + hstep, voffB); PG8_STAGE(PG8_SA(0, 0), a2, voffA);
            PG8_WAIT_V(8); PG8_WAIT_L(0); PG8_BAR; PG8_MMA(1, 0, At, B0); PG8_MMA(1, 1, At, B1); PG8_BAR; PG8_SCHED;
            PG8_LDB(B0, 1, 0); PG8_LDB(B1, 1, 1); PG8_SCHED; PG8_LDA(At, 1, 0); PG8_STAGE(PG8_SA(0, 1), a2 + hstep, voffA);
            PG8_WAIT_V(8); PG8_WAIT_L(0); PG8_BAR; PG8_MMA(0, 0, At, B0); PG8_MMA(0, 1, At, B1); PG8_BAR; PG8_SCHED;
            PG8_LDA(At, 1, 1); PG8_STAGE(PG8_SB(1, 0), b3, voffB); PG8_STAGE(PG8_SB(1, 1), b3 + hstep, voffB); PG8_STAGE(PG8_SA(1, 0), a3, voffA);
            PG8_WAIT_V(8); PG8_WAIT_L(0); PG8_BAR; PG8_MMA(1, 0, At, B0); PG8_MMA(1, 1, At, B1); PG8_BAR; PG8_SCHED;
            } else {
            PG8_LDB(B0, 0, 0); PG8_SCHED; PG8_LDA(At, 0, 0); PG8_STAGE(PG8_SA(1, 1), a1 + hstep, voffA);
            PG8_WAIT_L(8); PG8_BAR; PG8_WAIT_L(0); PG8_MMA(0, 0, At, B0); PG8_BAR; PG8_SCHED;
            PG8_LDB(B1, 0, 1); PG8_STAGE(PG8_SB(0, 0), b2, voffB);
            PG8_BAR; PG8_WAIT_L(0); PG8_MMA(0, 1, At, B1); PG8_BAR;
            PG8_LDA(At, 0, 1); PG8_STAGE(PG8_SA(0, 0), a2, voffA);
            PG8_BAR; PG8_WAIT_L(0); PG8_MMA(1, 0, At, B0); PG8_BAR; PG8_SCHED;
            PG8_STAGE(PG8_SB(0, 1), b2 + hstep, voffB);
            PG8_WAIT_V(6); PG8_BAR; PG8_MMA(1, 1, At, B1); PG8_BAR;
            PG8_LDB(B0, 1, 0); PG8_SCHED; PG8_LDA(At, 1, 0); PG8_STAGE(PG8_SA(0, 1), a2 + hstep, voffA);
            PG8_WAIT_L(8); PG8_BAR; PG8_WAIT_L(0); PG8_MMA(0, 0, At, B0); PG8_BAR; PG8_SCHED;
            PG8_LDB(B1, 1, 1); PG8_STAGE(PG8_SB(1, 0), b3, voffB);
            PG8_BAR; PG8_WAIT_L(0); PG8_MMA(0, 1, At, B1); PG8_BAR;
            PG8_LDA(At, 1, 1); PG8_STAGE(PG8_SA(1, 0), a3, voffA);
            PG8_BAR; PG8_WAIT_L(0); PG8_MMA(1, 0, At, B0); PG8_BAR; PG8_SCHED;
            PG8_STAGE(PG8_SB(1, 1), b3 + hstep, voffB);
            PG8_WAIT_V(6); PG8_BAR; PG8_MMA(1, 1, At, B1); PG8_BAR;
            }
        }
        if constexpr (ALIGN_EPI) { if (wr == 0) PG8_BAR; }
        if constexpr (!Epi::AFTER_DRAIN) { E(acc, cur, wr, wc, fr, fq); S.done(cur); }
        if (!has_next) break;
#pragma unroll
        for (int a = 0; a < 2; ++a)
#pragma unroll
            for (int b = 0; b < 2; ++b)
#pragma unroll
                for (int m = 0; m < 4; ++m)
#pragma unroll
                    for (int n = 0; n < 2; ++n) acc[a][b][m][n] = (f32x4){0.f, 0.f, 0.f, 0.f};
        cur = nxt; cA = nA; cB = nB; ++ui;
        if constexpr (ALIGN_EPI) { if (wr == 1) PG8_BAR; }
    }
    PG8_WAIT_V(0);
    if constexpr (!ALIGN_EPI) { if (wr == 0) PG8_BAR; }
    PG8_BAR;
    if constexpr (Epi::AFTER_DRAIN) { E.fused(acc, cur, wr, wc, fr, fq, lds, wid, lane); S.done(cur); }
#undef PG8_SA
#undef PG8_SB
#undef PG8_STAGE
#undef PG8_LDA
#undef PG8_LDB
#undef PG8_MMA
#undef PG8_WAIT_V
#undef PG8_WAIT_L
#undef PG8_BAR
#undef PG8_SCHED
}
}
namespace cg = cooperative_groups;
#define LAS __attribute__((address_space(3)))
typedef unsigned short bf16_t;
typedef short bf16x8 __attribute__((ext_vector_type(8)));
typedef float f32x4 __attribute__((ext_vector_type(4)));
typedef unsigned u32x4 __attribute__((ext_vector_type(4)));
typedef unsigned u32x2 __attribute__((ext_vector_type(2)));
typedef __bf16 bf16x2_n __attribute__((ext_vector_type(2)));
typedef float f32x2 __attribute__((ext_vector_type(2)));

constexpr int T = 16384, SEQ = 2048, D = 2048, FF = 5632, NGU = 2 * FF, NIN = 4608, QD = 1024, DEPTH = 2;
constexpr int ZP = FF;
constexpr float EPS = 1e-6f;
constexpr int NTHREADS = 512, NWAVES = 8;
constexpr int LDS_BYTES = 144 * 1024;
constexpr size_t SZ_GU = (size_t)NGU * D * 2, SZ_DN = (size_t)D * FF * 2, SZ_IN = (size_t)NIN * D * 2, SZ_OUT = (size_t)D * D * 2;
constexpr size_t OFF_GU1 = 0, OFF_D1 = OFF_GU1 + SZ_GU, OFF_IN = OFF_D1 + SZ_DN, OFF_OUT = OFF_IN + SZ_IN, OFF_GU2 = OFF_OUT + SZ_OUT, OFF_D2 = OFF_GU2 + SZ_GU, SZ_LAYER = OFF_D2 + SZ_DN;
constexpr size_t WS_W = 0, WS_XN = WS_W + DEPTH * SZ_LAYER, WS_BIG = WS_XN + (size_t)T * D * 2, WS_HF = WS_BIG + (size_t)T * FF * 2, WS_CTL = WS_HF + (size_t)T * D * 4, WS_LSE = WS_CTL + 32768, WS_RS = WS_LSE + (size_t)3 * T * 8 * 4, WS_LO = WS_RS + (size_t)T * 4, WS_END = WS_LO + (size_t)T * D * 2;
constexpr size_t OB_STRIDE = (size_t)T * QD;
constexpr size_t LSE_OFF = 3 * OB_STRIDE * 2;

struct Params { const float* in[16]; float* out; unsigned char* ws; };

__device__ __forceinline__ float wave_sum(float v) {
#pragma unroll
    for (int o = 1; o < 64; o <<= 1) v += __shfl_xor(v, o);
    return v;
}
__device__ __forceinline__ unsigned pk2(float lo, float hi) {
    const bf16x2_n r = __builtin_convertvector((f32x2){lo, hi}, bf16x2_n);
    return __builtin_bit_cast(unsigned, r);
}
__device__ __forceinline__ float bflo(unsigned w) { return __uint_as_float(w << 16); }
__device__ __forceinline__ float bfhi(unsigned w) { return __uint_as_float(w & 0xffff0000u); }
__device__ __forceinline__ float dot4(f32x4 a) { return (a.x * a.x + a.y * a.y) + (a.z * a.z + a.w * a.w); }

__device__ __forceinline__ void transpose_item(const float* W, int K, int N, bf16_t* WT, bool gu, LAS unsigned* scr, int item, int lane) {
    const int nblk = N / 64, kb = item / nblk, nb = item - kb * nblk, k0 = 64 * kb, n0 = 64 * nb;
    const int n4 = lane & 15, kq = lane >> 4;
    const float* src = W + (size_t)(k0 + 2 * kq) * N + n0 + 4 * n4;
    f32x4 L0[8], L1[8];
#pragma unroll
    for (int i = 0; i < 8; ++i) { L0[i] = *(const f32x4*)(src + (size_t)(8 * i) * N); L1[i] = *(const f32x4*)(src + (size_t)(8 * i + 1) * N); }
#pragma unroll
    for (int i = 0; i < 8; ++i) { const int kp = 4 * i + kq;
#pragma unroll
        for (int j = 0; j < 4; ++j) scr[(4 * n4 + j) * 33 + kp] = pk2(L0[i][j], L1[i][j]); }
    asm volatile("s_waitcnt lgkmcnt(0)" ::: "memory");
    int row0 = n0;
    if (gu) { const int up = n0 >= FF, nn = up ? n0 - FF : n0; row0 = 256 * (nn >> 7) + (up ? 128 : 0) + (nn & 127); }
    const int c = lane & 7;
#pragma unroll
    for (int j = 0; j < 8; ++j) { const int n = (lane >> 3) + 8 * j; const LAS unsigned* s = scr + n * 33 + 4 * c;
        u32x4 o; o.x = s[0]; o.y = s[1]; o.z = s[2]; o.w = s[3];
        *(u32x4*)(WT + (size_t)(row0 + n) * K + k0 + 8 * c) = o; }
    asm volatile("s_waitcnt lgkmcnt(0)" ::: "memory");
}
constexpr int IT_GU = (D / 64) * (NGU / 64), IT_DN = (FF / 64) * (D / 64), IT_IN = (D / 64) * (NIN / 64), IT_OUT = (D / 64) * (D / 64);
constexpr int IT_LAYER = 2 * IT_GU + 2 * IT_DN + IT_IN + IT_OUT;

__device__ __forceinline__ void prologue_phase(const Params& p, LAS unsigned char* lds, int gw, int ngw, int wave, int lane) {
    LAS unsigned* scr = (LAS unsigned*)(lds + wave * 16384);
    unsigned char* wsw = p.ws + WS_W;
    for (int it = gw; it < DEPTH * IT_LAYER; it += ngw) {
        const int l = it / IT_LAYER; int r = it - l * IT_LAYER;
        unsigned char* wl = wsw + (size_t)l * SZ_LAYER;
        if (r < IT_GU) { transpose_item(p.in[2] + (size_t)l * D * NGU, D, NGU, (bf16_t*)(wl + OFF_GU1), true, scr, r, lane); continue; } r -= IT_GU;
        if (r < IT_DN) { transpose_item(p.in[3] + (size_t)l * FF * D, FF, D, (bf16_t*)(wl + OFF_D1), false, scr, r, lane); continue; } r -= IT_DN;
        if (r < IT_IN) { transpose_item(p.in[6] + (size_t)l * D * NIN, D, NIN, (bf16_t*)(wl + OFF_IN), false, scr, r, lane); continue; } r -= IT_IN;
        if (r < IT_OUT) { transpose_item(p.in[10] + (size_t)l * D * D, D, D, (bf16_t*)(wl + OFF_OUT), false, scr, r, lane); continue; } r -= IT_OUT;
        if (r < IT_GU) { transpose_item(p.in[13] + (size_t)l * D * NGU, D, NGU, (bf16_t*)(wl + OFF_GU2), true, scr, r, lane); continue; } r -= IT_GU;
        transpose_item(p.in[14] + (size_t)l * FF * D, FF, D, (bf16_t*)(wl + OFF_D2), false, scr, r, lane);
    }
    const float* x = p.in[0]; const f32x4* g4 = (const f32x4*)p.in[1]; bf16_t* XN = (bf16_t*)(p.ws + WS_XN);
    for (int row = gw; row < T; row += ngw) {
        const f32x4* xr = (const f32x4*)(x + (size_t)row * D) + lane; f32x4 v[8]; float ss = 0.f;
#pragma unroll
        for (int j = 0; j < 8; ++j) { v[j] = xr[64 * j]; ss += dot4(v[j]); }
        const float rs = rsqrtf(wave_sum(ss) * (1.f / D) + EPS);
        u32x2* o = (u32x2*)(XN + (size_t)row * D) + lane;
#pragma unroll
        for (int j = 0; j < 8; ++j) { const f32x4 y = v[j] * rs * g4[lane + 64 * j]; o[64 * j] = (u32x2){pk2(y.x, y.y), pk2(y.z, y.w)}; }
    }
}

__device__ __forceinline__ f32x4 bf4lo(u32x4 w) { return (f32x4){bflo(w.x), bfhi(w.x), bflo(w.y), bfhi(w.y)}; }
__device__ __forceinline__ f32x4 bf4hi(u32x4 w) { return (f32x4){bflo(w.z), bfhi(w.z), bflo(w.w), bfhi(w.w)}; }
__device__ __forceinline__ f32x4 rcp4(f32x4 g) { return (f32x4){__builtin_amdgcn_rcpf(g.x), __builtin_amdgcn_rcpf(g.y), __builtin_amdgcn_rcpf(g.z), __builtin_amdgcn_rcpf(g.w)}; }
__device__ __forceinline__ void normres_phase(const bf16_t* hf, const float* xsrc, const float* gprev, bf16_t* HI, bf16_t* LO, float* RS, float* xdst, const float* gpost, float w, const float* gpre,
                                              int row0, int rstride, int nrows, unsigned* ctr, int poolbase, int npool, int lane) {
    const int nstat = (nrows + 1) >> 1; unsigned vnext = 0u;
    for (int trip = 0; ; ++trip) {
        int row, rowb; bool two;
        if (trip < nstat) {
            row = row0 + 2 * trip * rstride; if (row >= T) break;
            two = (2 * trip + 1 < nrows) && (row + rstride < T); rowb = two ? row + rstride : row;
            if (ctr != nullptr && trip == nstat - 1 && lane == 0) vnext = __hip_atomic_fetch_add(ctr, 1u, __ATOMIC_RELAXED, __HIP_MEMORY_SCOPE_AGENT);
        } else {
            if (ctr == nullptr) break;
            const unsigned pcur = (unsigned)__builtin_amdgcn_readfirstlane((int)vnext); if (pcur >= (unsigned)npool) break;
            row = poolbase + 2 * (int)pcur; rowb = row + 1; two = true;
            if (lane == 0) vnext = __hip_atomic_fetch_add(ctr, 1u, __ATOMIC_RELAXED, __HIP_MEMORY_SCOPE_AGENT);
        }
        u32x4 hw[2][4]; f32x4 xv[2][8];
        if (xsrc) {
#pragma unroll
            for (int q = 0; q < 2; ++q) { const int rr = q ? rowb : row;
                const u32x4* hr = (const u32x4*)(hf + (size_t)rr * D) + lane; const f32x4* xr = (const f32x4*)(xsrc + (size_t)rr * D) + 2 * lane;
#pragma unroll
                for (int c = 0; c < 4; ++c) { hw[q][c] = hr[64 * c]; xv[q][2 * c] = xr[128 * c]; xv[q][2 * c + 1] = xr[128 * c + 1]; } }
        } else {
            u32x4 hiw[2][4], low[2][4]; float rsp[2];
#pragma unroll
            for (int q = 0; q < 2; ++q) { const int rr = q ? rowb : row;
                const u32x4* hr = (const u32x4*)(hf + (size_t)rr * D) + lane; const u32x4* ar = (const u32x4*)(HI + (size_t)rr * D) + lane; const u32x4* br = (const u32x4*)(LO + (size_t)rr * D) + lane;
                rsp[q] = RS[rr];
#pragma unroll
                for (int c = 0; c < 4; ++c) { hw[q][c] = hr[64 * c]; hiw[q][c] = ar[64 * c]; low[q][c] = br[64 * c]; } }
            const f32x4* gv4 = (const f32x4*)gprev + 2 * lane;
#pragma unroll
            for (int c = 0; c < 4; ++c) { const f32x4 ig0 = rcp4(gv4[128 * c]), ig1 = rcp4(gv4[128 * c + 1]);
#pragma unroll
                for (int q = 0; q < 2; ++q) { const float inv = __builtin_amdgcn_rcpf(rsp[q]);
                    xv[q][2 * c] = (bf4lo(hiw[q][c]) + bf4lo(low[q][c])) * ig0 * inv; xv[q][2 * c + 1] = (bf4hi(hiw[q][c]) + bf4hi(low[q][c])) * ig1 * inv; } }
        }
#pragma unroll
        for (int q = 0; q < 2; ++q) { if (q == 1 && !two) break; const int rr = q ? rowb : row;
            float ss = 0.f;
#pragma unroll
            for (int c = 0; c < 4; ++c) ss += dot4(bf4lo(hw[q][c])) + dot4(bf4hi(hw[q][c]));
            const float rs = rsqrtf(wave_sum(ss) * (1.f / D) + EPS) * w; float ss2 = 0.f;
            const f32x4* gp4 = (const f32x4*)gpost + 2 * lane;
#pragma unroll
            for (int c = 0; c < 4; ++c) { xv[q][2 * c] = xv[q][2 * c] + bf4lo(hw[q][c]) * rs * gp4[128 * c]; xv[q][2 * c + 1] = xv[q][2 * c + 1] + bf4hi(hw[q][c]) * rs * gp4[128 * c + 1];
                ss2 += dot4(xv[q][2 * c]) + dot4(xv[q][2 * c + 1]); }
            if (xdst) {
                f32x4* xo = (f32x4*)(xdst + (size_t)rr * D) + 2 * lane;
#pragma unroll
                for (int c = 0; c < 4; ++c) { xo[128 * c] = xv[q][2 * c]; xo[128 * c + 1] = xv[q][2 * c + 1]; }
            } else {
                const float rs2 = rsqrtf(wave_sum(ss2) * (1.f / D) + EPS);
                const f32x4* gn4 = (const f32x4*)gpre + 2 * lane; u32x4* oh = (u32x4*)(HI + (size_t)rr * D) + lane; u32x4* ol = (u32x4*)(LO + (size_t)rr * D) + lane;
#pragma unroll
                for (int c = 0; c < 4; ++c) { const f32x4 y0 = xv[q][2 * c] * rs2 * gn4[128 * c], y1 = xv[q][2 * c + 1] * rs2 * gn4[128 * c + 1];
                    const u32x4 hh = (u32x4){pk2(y0.x, y0.y), pk2(y0.z, y0.w), pk2(y1.x, y1.y), pk2(y1.z, y1.w)};
                    const f32x4 r0 = y0 - bf4lo(hh), r1 = y1 - bf4hi(hh);
                    oh[64 * c] = hh; ol[64 * c] = (u32x4){pk2(r0.x, r0.y), pk2(r0.z, r0.w), pk2(r1.x, r1.y), pk2(r1.z, r1.w)}; }
                if (lane == 0) RS[rr] = rs2;
            }
        }
    }
}

constexpr int KS_STRIDE = 272, VT_STRIDE = 528, VT_OFF = 256 * KS_STRIDE;
static_assert(VT_OFF + 128 * VT_STRIDE <= LDS_BYTES, "attention LDS");
#define MFMA16(a, b, c) __builtin_amdgcn_mfma_f32_16x16x32_bf16((a), (b), (c), 0, 0, 0)
__device__ __forceinline__ void attn_phase(LAS unsigned char* lds, bf16_t* Z, bf16_t* OB12, float* LSE, int it0, int itstride, int nit, int tid) {
    const int wid = __builtin_amdgcn_readfirstlane(tid >> 6), lane = tid & 63, l15 = lane & 15, quad = lane >> 4;
    for (int ki = 0, it = it0; ki < nit && it < 768; ++ki, it += itstride) {
        const int sub = it & 15, br = (it >> 4) % 3, bg = it / 48, g = bg & 1, b = bg >> 1;
        int d, n, e; if (br == 0) { d = 1; n = sub; e = 0; } else if (br == 1) { d = 4; n = sub >> 2; e = sub & 3; } else { d = 16; n = 0; e = sub; }
        __syncthreads();
        {
            const int kp = tid >> 2, qtr = tid & 3, kj0 = 2 * kp;
            const bool valid = (n > 0) || (kj0 >= 128);
            u32x4 k0[4], k1[4], v0[4], v1[4];
            if (valid) {
                const int p0 = ((n - 1) * 128 + kj0) * d + e;
                const bf16_t* r0 = Z + (size_t)(b * SEQ + p0) * ZP + g * 128 + qtr * 32; const bf16_t* r1 = r0 + (size_t)d * ZP;
#pragma unroll
                for (int i = 0; i < 4; ++i) { k0[i] = *(const u32x4*)(r0 + 1024 + 8 * i); k1[i] = *(const u32x4*)(r1 + 1024 + 8 * i); v0[i] = *(const u32x4*)(r0 + 1280 + 8 * i); v1[i] = *(const u32x4*)(r1 + 1280 + 8 * i); }
            } else {
#pragma unroll
                for (int i = 0; i < 4; ++i) { k0[i] = (u32x4){0u, 0u, 0u, 0u}; k1[i] = k0[i]; v0[i] = k0[i]; v1[i] = k0[i]; }
            }
#pragma unroll
            for (int i = 0; i < 4; ++i) {
                *(LAS u32x4*)(lds + kj0 * KS_STRIDE + (qtr * 32 + 8 * i) * 2) = k0[i];
                *(LAS u32x4*)(lds + (kj0 + 1) * KS_STRIDE + (qtr * 32 + 8 * i) * 2) = k1[i];
#pragma unroll
                for (int w = 0; w < 4; ++w) { const unsigned a = v0[i][w], c = v1[i][w]; const int hd = qtr * 32 + 8 * i + 2 * w;
                    *(LAS unsigned*)(lds + VT_OFF + hd * VT_STRIDE + kj0 * 2) = (a & 0xffffu) | (c << 16);
                    *(LAS unsigned*)(lds + VT_OFF + (hd + 1) * VT_STRIDE + kj0 * 2) = (a >> 16) | (c & 0xffff0000u); }
            }
        }
        __syncthreads();
#pragma unroll 1
        for (int pass = 0; pass < 2; ++pass) {
            const int task = wid + 8 * pass, r = task & 3, c = task >> 2, head = g * 4 + r;
            const int kt0 = (n == 0) ? (8 - 2 * c) : 0;
            bf16x8 qf[2][4];
#pragma unroll
            for (int qt = 0; qt < 2; ++qt) { const int i = 32 * c + 16 * qt + l15; const size_t tok = (size_t)b * SEQ + (size_t)((n * 128 + i) * d + e);
                const bf16_t* qr = Z + tok * ZP + head * 128 + quad * 8;
#pragma unroll
                for (int ks = 0; ks < 4; ++ks) qf[qt][ks] = *(const bf16x8*)(qr + ks * 32); }
            f32x4 sacc[10][2];
#pragma unroll
            for (int kt = 0; kt < 10; ++kt) { sacc[kt][0] = (f32x4){0.f, 0.f, 0.f, 0.f}; sacc[kt][1] = sacc[kt][0]; }
#pragma unroll
            for (int kt = 0; kt < 10; ++kt) if (kt >= kt0) {
#pragma unroll
                for (int ks = 0; ks < 4; ++ks) { const bf16x8 kf = *(const LAS bf16x8*)(lds + (32 * c + 16 * kt + l15) * KS_STRIDE + (ks * 32 + quad * 8) * 2);
                    sacc[kt][0] = MFMA16(kf, qf[0][ks], sacc[kt][0]); sacc[kt][1] = MFMA16(kf, qf[1][ks], sacc[kt][1]); }
            }
            const float SC = 0.08838834764831845f * 1.4426950408889634f;
            float mrow[2], lrow[2];
#pragma unroll
            for (int qt = 0; qt < 2; ++qt) { const int i = 32 * c + 16 * qt + l15; float mx = -__builtin_inff();
#pragma unroll
                for (int kt = 0; kt < 10; ++kt)
#pragma unroll
                    for (int j = 0; j < 4; ++j) { const int kj = 32 * c + 16 * kt + 4 * quad + j; const bool ok = (kj >= i) && (kj <= i + 128) && (n > 0 || kj >= 128);
                        const float s = ok ? sacc[kt][qt][j] * SC : -__builtin_inff(); sacc[kt][qt][j] = s; mx = fmaxf(mx, s); }
                mx = fmaxf(mx, __shfl_xor(mx, 16)); mx = fmaxf(mx, __shfl_xor(mx, 32));
                float l = 0.f;
#pragma unroll
                for (int kt = 0; kt < 10; ++kt)
#pragma unroll
                    for (int j = 0; j < 4; ++j) { const float pv = __builtin_amdgcn_exp2f(sacc[kt][qt][j] - mx); sacc[kt][qt][j] = pv; l += pv; }
                l += __shfl_xor(l, 16); l += __shfl_xor(l, 32);
                mrow[qt] = mx; lrow[qt] = l; }
            bf16x8 pf[5][2];
#pragma unroll
            for (int kp = 0; kp < 5; ++kp)
#pragma unroll
                for (int qt = 0; qt < 2; ++qt) { const f32x4 a = sacc[2 * kp][qt], c2 = sacc[2 * kp + 1][qt];
                    const u32x4 w = (u32x4){pk2(a[0], a[1]), pk2(a[2], a[3]), pk2(c2[0], c2[1]), pk2(c2[2], c2[3])}; pf[kp][qt] = __builtin_bit_cast(bf16x8, w); }
            f32x4 oacc[8][2];
#pragma unroll
            for (int ht = 0; ht < 8; ++ht) { oacc[ht][0] = (f32x4){0.f, 0.f, 0.f, 0.f}; oacc[ht][1] = oacc[ht][0]; }
#pragma unroll
            for (int kp = 0; kp < 5; ++kp) if (2 * kp >= kt0) {
#pragma unroll
                for (int ht = 0; ht < 8; ++ht) { const LAS unsigned char* vp = lds + VT_OFF + (16 * ht + l15) * VT_STRIDE + (32 * c + 32 * kp + 4 * quad) * 2;
                    const u32x2 lo = *(const LAS u32x2*)vp, hi = *(const LAS u32x2*)(vp + 32);
                    const bf16x8 vf = __builtin_bit_cast(bf16x8, ((u32x4){lo.x, lo.y, hi.x, hi.y}));
                    oacc[ht][0] = MFMA16(vf, pf[kp][0], oacc[ht][0]); oacc[ht][1] = MFMA16(vf, pf[kp][1], oacc[ht][1]); }
            }
#pragma unroll
            for (int qt = 0; qt < 2; ++qt) { const int i = 32 * c + 16 * qt + l15; const size_t tok = (size_t)b * SEQ + (size_t)((n * 128 + i) * d + e);
                const float inv = 1.0f / lrow[qt];
                bf16_t* op = (br == 0 ? Z + tok * ZP + NIN : OB12 + (size_t)b * SEQ * D + (size_t)(br - 1) * SEQ * QD + (tok - (size_t)b * SEQ) * QD) + head * 128 + 4 * quad;
#pragma unroll
                for (int ht = 0; ht < 8; ++ht) { const f32x4 o = oacc[ht][qt] * inv; *(u32x2*)(op + 16 * ht) = (u32x2){pk2(o.x, o.y), pk2(o.z, o.w)}; }
                if (quad == 0) LSE[((size_t)br * T + tok) * 8 + head] = mrow[qt] * 0.6931471805599453f + __logf(lrow[qt]); }
        }
    }
}

__device__ __forceinline__ void combine_phase(const bf16_t* Z, const bf16_t* OB12, const float* LSE, const float* convw, const float* ga, const float* gc, bf16_t* XN, int boff, int row0, int rstride, int nrows, int lane) {
    for (int kr = 0, t = row0; kr < nrows && t < T; ++kr, t += rstride) {
        const int s = t & (SEQ - 1);
        float av[2][8], cv[2][8]; float ssa = 0.f, ssc = 0.f;
#pragma unroll
        for (int j = 0; j < 2; ++j) { const int chunk = lane + 64 * j, col = chunk * 8, head = chunk >> 4;
            const float l0 = LSE[((size_t)0 * T + t) * 8 + head], l1 = LSE[((size_t)1 * T + t) * 8 + head], l2 = LSE[((size_t)2 * T + t) * 8 + head];
            const float mx = fmaxf(l0, fmaxf(l1, l2)); float w0 = __expf(l0 - mx), w1 = __expf(l1 - mx), w2 = __expf(l2 - mx); const float inv = 1.0f / (w0 + w1 + w2); w0 *= inv; w1 *= inv; w2 *= inv;
            const u32x4 o0 = *(const u32x4*)(Z + (size_t)t * ZP + NIN + col), o1 = *(const u32x4*)(OB12 + (size_t)(t >> 11) * SEQ * D + (size_t)s * QD + col), o2 = *(const u32x4*)(OB12 + (size_t)(t >> 11) * SEQ * D + (size_t)SEQ * QD + (size_t)s * QD + col);
#pragma unroll
            for (int w = 0; w < 4; ++w) { const float a0 = w0 * bflo(o0[w]) + w1 * bflo(o1[w]) + w2 * bflo(o2[w]), a1 = w0 * bfhi(o0[w]) + w1 * bfhi(o1[w]) + w2 * bfhi(o2[w]);
                av[j][2 * w] = a0; av[j][2 * w + 1] = a1; ssa += a0 * a0 + a1 * a1; } }
#pragma unroll
        for (int j = 0; j < 2; ++j) { const int ch = (lane + 64 * j) * 8; const bf16_t* zr = Z + (size_t)t * ZP;
            const u32x4 hc0 = *(const u32x4*)(zr + 1536 + ch), bg0 = *(const u32x4*)(zr + 2560 + ch), cg0 = *(const u32x4*)(zr + 3584 + ch);
            u32x4 hc1 = (u32x4){0u, 0u, 0u, 0u}, cg1 = hc1, hc2 = hc1, cg2 = hc1;
            if (s >= 1) { hc1 = *(const u32x4*)(zr - ZP + 1536 + ch); cg1 = *(const u32x4*)(zr - ZP + 3584 + ch); }
            if (s >= 2) { hc2 = *(const u32x4*)(zr - 2 * ZP + 1536 + ch); cg2 = *(const u32x4*)(zr - 2 * ZP + 3584 + ch); }
            float wk[3][8];
#pragma unroll
            for (int k = 0; k < 3; ++k) { const f32x4 a = *(const f32x4*)(convw + k * QD + ch), b2 = *(const f32x4*)(convw + k * QD + ch + 4);
                wk[k][0] = a.x; wk[k][1] = a.y; wk[k][2] = a.z; wk[k][3] = a.w; wk[k][4] = b2.x; wk[k][5] = b2.y; wk[k][6] = b2.z; wk[k][7] = b2.w; }
#pragma unroll
            for (int w = 0; w < 4; ++w) {
                const float y0 = wk[2][2 * w] * (bflo(cg0[w]) * bflo(hc0[w])) + wk[1][2 * w] * (bflo(cg1[w]) * bflo(hc1[w])) + wk[0][2 * w] * (bflo(cg2[w]) * bflo(hc2[w]));
                const float y1 = wk[2][2 * w + 1] * (bfhi(cg0[w]) * bfhi(hc0[w])) + wk[1][2 * w + 1] * (bfhi(cg1[w]) * bfhi(hc1[w])) + wk[0][2 * w + 1] * (bfhi(cg2[w]) * bfhi(hc2[w]));
                const float c0 = bflo(bg0[w]) * y0, c1 = bfhi(bg0[w]) * y1; cv[j][2 * w] = c0; cv[j][2 * w + 1] = c1; ssc += c0 * c0 + c1 * c1; } }
        const float ra = rsqrtf(wave_sum(ssa) * (1.f / QD) + EPS), rc = rsqrtf(wave_sum(ssc) * (1.f / QD) + EPS);
#pragma unroll
        for (int j = 0; j < 2; ++j) { const int col = (lane + 64 * j) * 8;
            const f32x4 g0 = *(const f32x4*)(ga + col), g1 = *(const f32x4*)(ga + col + 4), h0 = *(const f32x4*)(gc + col), h1 = *(const f32x4*)(gc + col + 4);
            u32x4 oa, oc;
            oa.x = pk2(av[j][0] * ra * g0.x, av[j][1] * ra * g0.y); oa.y = pk2(av[j][2] * ra * g0.z, av[j][3] * ra * g0.w); oa.z = pk2(av[j][4] * ra * g1.x, av[j][5] * ra * g1.y); oa.w = pk2(av[j][6] * ra * g1.z, av[j][7] * ra * g1.w);
            oc.x = pk2(cv[j][0] * rc * h0.x, cv[j][1] * rc * h0.y); oc.y = pk2(cv[j][2] * rc * h0.z, cv[j][3] * rc * h0.w); oc.z = pk2(cv[j][4] * rc * h1.x, cv[j][5] * rc * h1.y); oc.w = pk2(cv[j][6] * rc * h1.z, cv[j][7] * rc * h1.w);
            bf16_t* xo = XN + (size_t)t * D + (size_t)(t >> 11) * boff;
            *(u32x4*)(xo + col) = oa; *(u32x4*)(xo + QD + col) = oc; }
    }
}

#define XB_TMO      128
#define XB_XCNT(j)  (256  + 64 * (j))
#define XB_XSUB(j)  (1280 + 64 * (j))
#define XB_XGEN(j)  (2304 + 64 * (j))
#define XB_TOP      3328
#define XB_TOPGEN   3392
#define XCD_BAR_WORDS 3456
#define XB_SPIN_CAP (1u << 18)
__device__ __forceinline__ unsigned xb_ld(unsigned* p)              { return __hip_atomic_load(p, __ATOMIC_RELAXED, __HIP_MEMORY_SCOPE_AGENT); }
__device__ __forceinline__ unsigned xb_add(unsigned* p, unsigned v) { return __hip_atomic_fetch_add(p, v, __ATOMIC_RELAXED, __HIP_MEMORY_SCOPE_AGENT); }
__device__ __forceinline__ unsigned xb_xcc_id() { return (unsigned)__builtin_amdgcn_s_getreg((3 << 11) | 20) & 0xFu; }
#define XB_SPIN(cond, bar) do { unsigned _sp = 0; while (cond) { __builtin_amdgcn_s_sleep(1); \
    if ((++_sp & 255u) == 0u) { if (xb_ld(&(bar)[XB_TMO])) break; if (_sp > XB_SPIN_CAP) { atomicAdd(&(bar)[XB_TMO], 1u); break; } } } } while (0)
__device__ __forceinline__ void xcd_barrier_complete(unsigned* bar, unsigned x, unsigned& nloc, unsigned& nx) {
    const unsigned G = gridDim.x * gridDim.y * gridDim.z;
    unsigned sum, cnt, mine, sp = 0u;
    for (;;) {
        sum = 0u; cnt = 0u; mine = 0u;
#pragma unroll
        for (unsigned j = 0; j < 16; ++j) { const unsigned c = xb_ld(&bar[XB_XCNT(j)]); sum += c; cnt += (c > 0u) ? 1u : 0u; mine = (j == x) ? c : mine; }
        if (sum == G) break;
        __builtin_amdgcn_s_sleep(1);
        if ((++sp & 255u) == 0u) { if (xb_ld(&bar[XB_TMO])) break; if (sp > XB_SPIN_CAP) { atomicAdd(&bar[XB_TMO], 1u); break; } }
    }
    nloc = mine > 0u ? mine : 1u; nx = cnt > 0u ? cnt : 1u;
}
__device__ __forceinline__ void xcd_barrier(unsigned* bar, volatile LAS unsigned* st, int tid) {
    asm volatile("s_waitcnt vmcnt(0)" ::: "memory");
    __syncthreads();
    if (tid == 0) {
        const unsigned x = xb_xcc_id();
        __builtin_amdgcn_s_waitcnt(0);
        unsigned nloc = st[0], nx = st[1];
        if (nloc == 0u) { xcd_barrier_complete(bar, x, nloc, nx); st[0] = nloc; st[1] = nx; }
        const unsigned old = xb_add(&bar[XB_XSUB(x)], 1u);
        const unsigned gen = old / nloc;
        if (old + 1u == (gen + 1u) * nloc) {
            __builtin_amdgcn_fence(__ATOMIC_RELEASE, "agent");
            asm volatile("s_waitcnt vmcnt(0)" ::: "memory");
            const unsigned og = xb_add(&bar[XB_TOP], 1u);
            const unsigned tg = og / nx;
            if (og + 1u == (tg + 1u) * nx) xb_add(&bar[XB_TOPGEN], 1u);
            else XB_SPIN(xb_ld(&bar[XB_TOPGEN]) == tg, bar);
            __builtin_amdgcn_fence(__ATOMIC_ACQUIRE, "agent");
            xb_add(&bar[XB_XGEN(x)], 1u);
            asm volatile("s_waitcnt vmcnt(0)" ::: "memory");
        } else {
            XB_SPIN(xb_ld(&bar[XB_XGEN(x)]) == gen, bar);
            __builtin_amdgcn_fence(__ATOMIC_ACQUIRE, "agent");
            asm volatile("s_waitcnt vmcnt(0)" ::: "memory");
        }
    }
    __syncthreads();
}
#define XL_WORD(x) (4096 + 64 * (x))
__device__ __forceinline__ void xcc_local_barrier(unsigned* cnt, unsigned target, int tid) {
    asm volatile("s_waitcnt vmcnt(0)" ::: "memory");
    __syncthreads();
    if (tid == 0) {
        __builtin_amdgcn_s_waitcnt(0);
        (void)xb_add(cnt, 1u);
        unsigned sp = 0u;
        while (xb_ld(cnt) < target) { __builtin_amdgcn_s_sleep(1); if (++sp > (1u << 24)) break; }
        __builtin_amdgcn_fence(__ATOMIC_ACQUIRE, "agent");
        asm volatile("s_waitcnt vmcnt(0)" ::: "memory");
    }
    __syncthreads();
}
struct Ctx { int tid, lane, wave, G, bid, gw, ngw; };
__device__ __forceinline__ int make_tid(int wave_s) {
    int ln; asm volatile("v_mbcnt_lo_u32_b32 %0, -1, 0\n\tv_mbcnt_hi_u32_b32 %0, -1, %0" : "=&v"(ln));
    return wave_s * 64 + ln;
}
__device__ __forceinline__ Ctx make_ctx(int wave_s) {
    const int t = make_tid(wave_s);
    Ctx c; c.tid = t; c.lane = t & 63; c.wave = wave_s; c.G = gridDim.x; c.bid = blockIdx.x; c.gw = c.bid * NWAVES + c.wave; c.ngw = c.G * NWAVES; return c;
}
__device__ __forceinline__ const Params* get_params() {
    const Params* pp = (const Params*)__builtin_amdgcn_kernarg_segment_ptr(); asm volatile("" : "+s"(pp)); return pp;
}
__global__ void __launch_bounds__(NTHREADS) fwd_megakernel(Params p_unused) {
    extern __shared__ __attribute__((aligned(16))) unsigned char lds_raw[];
    LAS unsigned char* lds = (LAS unsigned char*)lds_raw;
    cg::grid_group grid = cg::this_grid();
    const int wave_s = __builtin_amdgcn_readfirstlane((int)threadIdx.x >> 6);
    volatile LAS unsigned* xst = (volatile LAS unsigned*)(lds + LDS_BYTES - 16);
    { unsigned* barp = (unsigned*)(get_params()->ws + WS_CTL); const unsigned xcc = xb_xcc_id();
      if (threadIdx.x == 0) { xst[0] = 0u; xst[1] = 0u; xst[2] = xb_add(&barp[XB_XCNT(xcc)], 1u); } }
    { const Params* pp = get_params(); const Ctx c = make_ctx(wave_s); prologue_phase(*pp, lds, c.gw, c.ngw, c.wave, c.lane); }
    __syncthreads();
    grid.sync();
    { unsigned* barp = (unsigned*)(get_params()->ws + WS_CTL);
      if (threadIdx.x == 0) { bool even = (gridDim.x == 256);
          for (unsigned j = 0; j < 16; ++j) { const unsigned cn = xb_ld(&barp[XB_XCNT(j)]); even = even && (j < 8 ? cn == 32u : cn == 0u); }
          xst[3] = even ? 1u : 0u; } }
    __syncthreads();
    const unsigned xcc_s = xb_xcc_id();
    const bool xlocal = __builtin_amdgcn_readfirstlane((int)xst[3]) != 0;
    const int vbid = xlocal ? (int)(__builtin_amdgcn_readfirstlane((int)xst[2]) * 8 + (int)xcc_s) : (int)blockIdx.x;
    const bool grouped = (gridDim.x == 256);
    const int vb_b = vbid & 7, vb_r = vbid >> 3;
    unsigned lk = 0u;
#define GRID_BAR() do { if (xlocal) { ++lk; xcc_local_barrier((unsigned*)(get_params()->ws + WS_CTL) + XL_WORD(xcc_s), 32u * lk, make_tid(wave_s)); } \
                        else xcd_barrier((unsigned*)(get_params()->ws + WS_CTL), xst, make_tid(wave_s)); } while (0)
#define ROW0(c) (grouped ? vb_b * SEQ + vb_r * 8 + (c).wave : (c).gw)
#define RSTRIDE(c) (grouped ? 256 : (c).ngw)
#define NROWS() (grouped ? 8 : T)
    unsigned nri = 0u;
#define DYN_WORD(i, b) (5120 + 16 * ((int)(i) * 8 + (b)))
#define NR_ARGS(c) ROW0(c), RSTRIDE(c), (grouped ? 4 : T), (grouped ? (unsigned*)(ws + WS_CTL) + DYN_WORD(nri, vb_b) : nullptr), vb_b * SEQ + 1024, 512, (c).lane
#pragma unroll 1
    for (int l = 0; l < DEPTH; ++l) {
#pragma unroll 1
        for (int f = 0; f < 2; ++f) {
            if (f == 1) {
                { const Params* pp = get_params(); unsigned char* ws = pp->ws; const int G = gridDim.x, bid = vbid;
                  pg8::Gemm g{(const bf16_t*)(ws + WS_XN), (const bf16_t*)(ws + WS_W + (size_t)l * SZ_LAYER + OFF_IN), T, NIN, D}; pg8::StaticOrder S; S.init(T, NIN, G, bid); pg8::EpiBf16 E{(bf16_t*)(ws + WS_BIG), ZP};
                  pg8::gemm_phase<pg8::EpiBf16, pg8::StaticOrder, true, true>(lds, g, S, E, make_tid(wave_s)); }
                GRID_BAR();
                { const Params* pp = get_params(); unsigned char* ws = pp->ws; const Ctx c = make_ctx(wave_s);
                  attn_phase(lds, (bf16_t*)(ws + WS_BIG), (bf16_t*)(ws + WS_HF + (size_t)T * D * 2), (float*)(ws + WS_LSE), grouped ? (vb_b * 2 + (vb_r & 1)) * 48 + (vb_r >> 1) : c.bid, grouped ? 16 : c.G, grouped ? 3 : 768, c.tid); }
                GRID_BAR();
                { const Params* pp = get_params(); unsigned char* ws = pp->ws; const Ctx c = make_ctx(wave_s);
                  combine_phase((const bf16_t*)(ws + WS_BIG), (const bf16_t*)(ws + WS_HF + (size_t)T * D * 2), (const float*)(ws + WS_LSE), pp->in[7] + (size_t)l * 3 * QD, pp->in[8] + (size_t)l * QD, pp->in[9] + (size_t)l * QD,
                                (bf16_t*)(ws + WS_HF), 0, ROW0(c), RSTRIDE(c), NROWS(), c.lane); }
                GRID_BAR();
                { const Params* pp = get_params(); unsigned char* ws = pp->ws; const int G = gridDim.x, bid = vbid;
                  pg8::Gemm g{(const bf16_t*)(ws + WS_HF), (const bf16_t*)(ws + WS_W + (size_t)l * SZ_LAYER + OFF_OUT), T, D, D}; pg8::StaticOrder S; S.init(T, D, G, bid); pg8::EpiBf16 E{(bf16_t*)(ws + WS_HF + (size_t)T * D * 2), D};
                  pg8::gemm_phase<pg8::EpiBf16, pg8::StaticOrder, true, true>(lds, g, S, E, make_tid(wave_s)); }
                GRID_BAR();
                { const Params* pp = get_params(); unsigned char* ws = pp->ws; const Ctx c = make_ctx(wave_s);
                  normres_phase((const bf16_t*)(ws + WS_HF + (size_t)T * D * 2), nullptr, pp->in[5] + (size_t)l * D, (bf16_t*)(ws + WS_XN), (bf16_t*)(ws + WS_LO), (float*)(ws + WS_RS), nullptr, pp->in[11] + (size_t)l * D, 1.0f, pp->in[12] + (size_t)l * D, NR_ARGS(c)); ++nri; }
                GRID_BAR();
            }
            { const Params* pp = get_params(); unsigned char* ws = pp->ws; const int G = gridDim.x, bid = vbid;
              pg8::Gemm g{(const bf16_t*)(ws + WS_XN), (const bf16_t*)(ws + WS_W + (size_t)l * SZ_LAYER + (f ? OFF_GU2 : OFF_GU1)), T, NGU, D}; pg8::StaticOrder S; S.init(T, NGU, G, bid); pg8::EpiSwiGLU E{(bf16_t*)(ws + WS_BIG), FF};
              pg8::gemm_phase<pg8::EpiSwiGLU, pg8::StaticOrder, true, true>(lds, g, S, E, make_tid(wave_s)); }
            GRID_BAR();
            { const Params* pp = get_params(); unsigned char* ws = pp->ws; const int G = gridDim.x, bid = vbid;
              pg8::Gemm g{(const bf16_t*)(ws + WS_BIG), (const bf16_t*)(ws + WS_W + (size_t)l * SZ_LAYER + (f ? OFF_D2 : OFF_D1)), T, D, FF}; pg8::StaticOrder S; S.init(T, D, G, bid); pg8::EpiBf16 E{(bf16_t*)(ws + WS_HF), D};
              pg8::gemm_phase<pg8::EpiBf16, pg8::StaticOrder, true, true>(lds, g, S, E, make_tid(wave_s)); }
            GRID_BAR();
            { const Params* pp = get_params(); unsigned char* ws = pp->ws; const Ctx c = make_ctx(wave_s);
              const float* gpost = (f ? pp->in[15] : pp->in[4]) + (size_t)l * D;
              const float* gpre = f ? (l + 1 < DEPTH ? pp->in[1] + (size_t)(l + 1) * D : nullptr) : pp->in[5] + (size_t)l * D;
              const float* gprev = (f ? pp->in[12] : pp->in[1]) + (size_t)l * D;
              const float* xsrc = (l == 0 && f == 0) ? pp->in[0] : nullptr;
              float* xdst = (l == DEPTH - 1 && f == 1) ? pp->out : nullptr;
              normres_phase((const bf16_t*)(ws + WS_HF), xsrc, gprev, (bf16_t*)(ws + WS_XN), (bf16_t*)(ws + WS_LO), (float*)(ws + WS_RS), xdst, gpost, 0.5f, gpre, NR_ARGS(c)); ++nri; }
            if (!(l == DEPTH - 1 && f == 1)) GRID_BAR();
        }
    }
}

extern "C" void kernel_launch(void* const* d_in, const int* in_sizes, int n_in, void* d_out, int out_size, void* d_ws, size_t ws_size, hipStream_t stream) {
    static int grid_blocks = 0;
    if (grid_blocks == 0) {
        if (n_in != 16 || out_size != T * D || ws_size < WS_END) { fprintf(stderr, "kernel_launch: unexpected shapes (n_in %d out %d ws %zu need %zu)\n", n_in, out_size, ws_size, (size_t)WS_END); grid_blocks = -1; return; }
        int dev = 0, cus = 0, per_cu = 0;
        hipGetDevice(&dev);
        hipDeviceGetAttribute(&cus, hipDeviceAttributeMultiprocessorCount, dev);
        if (hipFuncSetAttribute((const void*)fwd_megakernel, hipFuncAttributeMaxDynamicSharedMemorySize, LDS_BYTES) != hipSuccess) { fprintf(stderr, "kernel_launch: hipFuncSetAttribute failed\n"); }
        if (hipOccupancyMaxActiveBlocksPerMultiprocessor(&per_cu, (const void*)fwd_megakernel, NTHREADS, LDS_BYTES) != hipSuccess || per_cu < 1) { fprintf(stderr, "kernel_launch: occupancy query gave %d\n", per_cu); per_cu = 1; }
        (void)hipGetLastError();
        grid_blocks = cus * 1;
        if (grid_blocks <= 0) grid_blocks = 256;
    }
    if (grid_blocks < 0) return;
    Params p{};
    for (int i = 0; i < 16; ++i) p.in[i] = (const float*)d_in[i];
    p.out = (float*)d_out; p.ws = (unsigned char*)d_ws;
    if (hipMemsetAsync((unsigned char*)d_ws + WS_CTL, 0, 32768, stream) != hipSuccess) fprintf(stderr, "kernel_launch: memset of barrier words failed\n");
    void* args[] = {&p};
    hipError_t e = hipLaunchCooperativeKernel((const void*)fwd_megakernel, dim3(grid_blocks), dim3(NTHREADS), args, LDS_BYTES, stream);
    if (e != hipSuccess) fprintf(stderr, "cooperative launch failed: %s (grid %d)\n", hipGetErrorString(e), grid_blocks);
}
```

```cpp
#include <hip/hip_runtime.h>
#include <hip/hip_cooperative_groups.h>
#include <cstdio>
#include <cstdint>
namespace pg8 {
#define PG8_LAS __attribute__((address_space(3)))
typedef unsigned short bf16_t;
typedef short bf16x8 __attribute__((ext_vector_type(8)));
typedef float f32x4 __attribute__((ext_vector_type(4)));
typedef unsigned u32x4 __attribute__((ext_vector_type(4)));
constexpr int BM = 256, BK = 64, HALF = 128, HTB = HALF * BK * 2  , STAGE_BYTES = 8 * HTB, NXCD = 8, WGM = 8;

__host__ __device__ __forceinline__ int lds_byte(int r, int c) { const int st = (r >> 4) * 2 + (c >> 5), rr = r & 15, cc = c & 31, ob = rr * 64 + cc * 2; return st * 1024 + (ob ^ (((ob >> 9) & 1) << 5)); }
__host__ __device__ __forceinline__ void stage_rc(int b, int& R, int& C) { const int st = b / 1024, sb = b % 1024, swz = sb ^ (((sb >> 9) & 1) << 5); R = (st >> 1) * 16 + swz / 64; C = (st & 1) * 32 + (swz % 64) / 2; }
__host__ __device__ __forceinline__ int perm32(int rho) { const int n = rho >> 4, i = rho & 15; return 8 * (i >> 2) + 4 * n + (i & 3); }

struct Unit { int pm, pn; };
struct Gemm { const bf16_t* A; const bf16_t* Bt; int M, N, K; };

struct StaticOrder {
    int nM, nN, nwg, G, c;
    __host__ __device__ void init(int M, int N, int G_, int c_) { nM = M / BM; nN = N / BM; nwg = nM * nN; G = G_; c = c_; }
    __host__ __device__ bool next(int i, Unit& u) const {
        const long L = (long)i * G + c; if (L >= nwg) return false;
        int wgid = (int)L; { const int q = nwg / NXCD, r = nwg % NXCD, xcd = wgid % NXCD, off = wgid / NXCD; wgid = (xcd < r ? xcd * (q + 1) : r * (q + 1) + (xcd - r) * q) + off; }
        const int nig = WGM * nN, gid = wgid / nig, fm = gid * WGM, gsz = (nM - fm) < WGM ? (nM - fm) : WGM;
        u.pm = fm + ((wgid % nig) % gsz); u.pn = (wgid % nig) / gsz; return true;
    }
    __device__ __forceinline__ void a_ready(const Unit&) const {}
    __device__ __forceinline__ void done(const Unit&) const {}
};
__device__ __forceinline__ unsigned cvt_pk_bf16(float lo, float hi) { unsigned r; asm volatile("v_cvt_pk_bf16_f32 %0, %1, %2" : "=v"(r) : "v"(lo), "v"(hi)); return r; }
struct EpiF32 {
    static constexpr bool PERM = false, AFTER_DRAIN = false;
    float* C; int ldc;
    __device__ __forceinline__ void operator()(const f32x4 (&acc)[2][2][4][2], const Unit& u, int wr, int wc, int fr, int fq) const {
        const int row0 = u.pm * BM + wr * 64 + fr, col0 = u.pn * BM + wc * 32 + 4 * fq;
#pragma unroll
        for (int ai = 0; ai < 2; ++ai)
#pragma unroll
            for (int m = 0; m < 4; ++m) { float* rowp = C + (size_t)(row0 + ai * HALF + m * 16) * ldc + col0;
#pragma unroll
                for (int bj = 0; bj < 2; ++bj)
#pragma unroll
                    for (int n = 0; n < 2; ++n) *(f32x4*)(rowp + bj * HALF + n * 16) = acc[ai][bj][m][n]; }
    }
};
struct EpiBf16 {
    static constexpr bool PERM = true, AFTER_DRAIN = false;
    bf16_t* O; int ldc;
    __device__ __forceinline__ void operator()(const f32x4 (&acc)[2][2][4][2], const Unit& u, int wr, int wc, int fr, int fq) const {
        const int row0 = u.pm * BM + wr * 64 + fr, col0 = u.pn * BM + wc * 32 + 8 * fq;
#pragma unroll
        for (int ai = 0; ai < 2; ++ai)
#pragma unroll
            for (int m = 0; m < 4; ++m) { bf16_t* rowp = O + (size_t)(row0 + ai * HALF + m * 16) * ldc + col0;
#pragma unroll
                for (int bj = 0; bj < 2; ++bj) { const f32x4 v0 = acc[ai][bj][m][0], v1 = acc[ai][bj][m][1];
                    u32x4 w; w.x = cvt_pk_bf16(v0[0], v0[1]); w.y = cvt_pk_bf16(v0[2], v0[3]); w.z = cvt_pk_bf16(v1[0], v1[1]); w.w = cvt_pk_bf16(v1[2], v1[3]);
                    *(u32x4*)(rowp + bj * HALF) = w; } }
    }
};
__device__ __forceinline__ float silu_mul(float g, float u) { return g * u * __builtin_amdgcn_rcpf(1.0f + __builtin_amdgcn_exp2f(g * -1.4426950408889634f)); }
struct EpiSwiGLU {
    static constexpr bool PERM = true, AFTER_DRAIN = false;
    bf16_t* O; int ldc;
    __device__ __forceinline__ void operator()(const f32x4 (&acc)[2][2][4][2], const Unit& u, int wr, int wc, int fr, int fq) const {
        const int row0 = u.pm * BM + wr * 64 + fr, col0 = u.pn * HALF + wc * 32 + 8 * fq;
#pragma unroll
        for (int ai = 0; ai < 2; ++ai)
#pragma unroll
            for (int m = 0; m < 4; ++m) { bf16_t* rowp = O + (size_t)(row0 + ai * HALF + m * 16) * ldc + col0;
                const f32x4 g0 = acc[ai][0][m][0], g1 = acc[ai][0][m][1], u0 = acc[ai][1][m][0], u1 = acc[ai][1][m][1];
                u32x4 w; w.x = cvt_pk_bf16(silu_mul(g0[0], u0[0]), silu_mul(g0[1], u0[1])); w.y = cvt_pk_bf16(silu_mul(g0[2], u0[2]), silu_mul(g0[3], u0[3]));
                w.z = cvt_pk_bf16(silu_mul(g1[0], u1[0]), silu_mul(g1[1], u1[1])); w.w = cvt_pk_bf16(silu_mul(g1[2], u1[2]), silu_mul(g1[3], u1[3]));
                *(u32x4*)rowp = w; }
    }
};

template <class Epi, class Sched, bool ALIGN_EPI = false, bool SP2 = false>
__device__ __forceinline__ void gemm_phase(PG8_LAS unsigned char* lds, const Gemm g, const Sched& S, const Epi& E, int tid_in) {
    int tid_l = tid_in; asm volatile("" : "+v"(tid_l));
    const int tid = tid_l, wid = __builtin_amdgcn_readfirstlane(tid >> 6), lane = tid & 63, wr = wid >> 2, wc = wid & 3, fr = lane & 15, fq = lane >> 4;
    const int K = g.K, nt = K / BK;
    unsigned voffA[2], voffB[2];
#pragma unroll
    for (int i = 0; i < 2; ++i) { int R, C; stage_rc(tid * 16 + i * 8192, R, C); const int Rb = Epi::PERM ? ((R & ~31) + perm32(R & 31)) : R;
        voffA[i] = (unsigned)(R * K + C) * 2u; voffB[i] = (unsigned)(Rb * K + C) * 2u; }
    const size_t kstep = (size_t)(BK * 2);
    const size_t hstep = (size_t)HALF * K * 2;
    const size_t tstep = 2 * hstep;
    const unsigned ldsw = (unsigned)wid * 1024u;
    const int aoff = lds_byte(wr * 64 + fr, fq * 8), boff = lds_byte(wc * 32 + fr, fq * 8);
#define PG8_SA(b, h) (((b) * 2 + (h)) * HTB)
#define PG8_SB(b, h) ((4 + (b) * 2 + (h)) * HTB)
#define PG8_STAGE(bufoff, gbase, voff) do { _Pragma("unroll") for (int _i = 0; _i < 2; ++_i) \
        __builtin_amdgcn_global_load_lds((const unsigned*)((const char*)(gbase) + (voff)[_i]), (PG8_LAS unsigned*)(lds + (bufoff) + ldsw + _i * 8192), 16, 0, 0); } while (0)
#define PG8_LDA(dst, b, h) do { _Pragma("unroll") for (int m = 0; m < 4; ++m) _Pragma("unroll") for (int k = 0; k < 2; ++k) dst[m][k] = *(const PG8_LAS bf16x8*)(lds + PG8_SA(b, h) + aoff + m * 2048 + k * 1024); } while (0)
#define PG8_LDB(dst, b, h) do { _Pragma("unroll") for (int n = 0; n < 2; ++n) _Pragma("unroll") for (int k = 0; k < 2; ++k) dst[n][k] = *(const PG8_LAS bf16x8*)(lds + PG8_SB(b, h) + boff + n * 2048 + k * 1024); } while (0)
#define PG8_MMA(ai, bj, At, Bt) do { __builtin_amdgcn_s_setprio(1); _Pragma("unroll") for (int m = 0; m < 4; ++m) _Pragma("unroll") for (int n = 0; n < 2; ++n) _Pragma("unroll") for (int k = 0; k < 2; ++k) \
        acc[ai][bj][m][n] = __builtin_amdgcn_mfma_f32_16x16x32_bf16(Bt[n][k], At[m][k], acc[ai][bj][m][n], 0, 0, 0); __builtin_amdgcn_s_setprio(0); } while (0)
#define PG8_WAIT_V(n) asm volatile("s_waitcnt vmcnt(" #n ")" ::: "memory")
#define PG8_WAIT_L(n) asm volatile("s_waitcnt lgkmcnt(" #n ")" ::: "memory")
#define PG8_BAR __builtin_amdgcn_s_barrier()
#define PG8_SCHED __builtin_amdgcn_sched_barrier(0)
    Unit cur, nxt; int ui = 0;
    if (!S.next(0, cur)) return;
    f32x4 acc[2][2][4][2];
#pragma unroll
    for (int a = 0; a < 2; ++a)
#pragma unroll
        for (int b = 0; b < 2; ++b)
#pragma unroll
            for (int m = 0; m < 4; ++m)
#pragma unroll
                for (int n = 0; n < 2; ++n) acc[a][b][m][n] = (f32x4){0.f, 0.f, 0.f, 0.f};
    bf16x8 At[4][2], B0[2][2], B1[2][2];
    const char* cA = (const char*)g.A + (size_t)cur.pm * tstep; const char* cB = (const char*)g.Bt + (size_t)cur.pn * tstep;
    S.a_ready(cur);
    if constexpr (SP2) {
        PG8_STAGE(PG8_SB(0, 0), cB, voffB); PG8_STAGE(PG8_SB(0, 1), cB + hstep, voffB); PG8_STAGE(PG8_SA(0, 0), cA, voffA); PG8_STAGE(PG8_SA(0, 1), cA + hstep, voffA);
        if (wr == 1) PG8_BAR;
        PG8_WAIT_V(2); PG8_BAR;
        PG8_STAGE(PG8_SB(1, 0), cB + kstep, voffB); PG8_STAGE(PG8_SA(1, 0), cA + kstep, voffA); PG8_STAGE(PG8_SB(1, 1), cB + hstep + kstep, voffB);
        PG8_WAIT_V(6); PG8_BAR;
    } else {
        PG8_STAGE(PG8_SB(0, 0), cB, voffB); PG8_STAGE(PG8_SA(0, 0), cA, voffA); PG8_STAGE(PG8_SB(0, 1), cB + hstep, voffB); PG8_STAGE(PG8_SA(0, 1), cA + hstep, voffA);
        if (wr == 1) PG8_BAR;
        PG8_WAIT_V(4); PG8_BAR;
        PG8_STAGE(PG8_SB(1, 0), cB + kstep, voffB); PG8_STAGE(PG8_SA(1, 0), cA + kstep, voffA); PG8_STAGE(PG8_SB(1, 1), cB + hstep + kstep, voffB);
        PG8_WAIT_V(6); PG8_BAR;
    }
    for (;;) {
        const bool has_next = S.next(ui + 1, nxt);
        const char* nA = has_next ? (const char*)g.A + (size_t)nxt.pm * tstep : cA; const char* nB = has_next ? (const char*)g.Bt + (size_t)nxt.pn * tstep : cB;
        for (int t = 0; t < nt; t += 2) {
            const bool last = (t == nt - 2);
            const char* a1 = cA + (size_t)(t + 1) * kstep;
            const char* a2 = last ? nA : cA + (size_t)(t + 2) * kstep; const char* b2 = last ? nB : cB + (size_t)(t + 2) * kstep;
            const char* a3 = a2 + kstep; const char* b3 = b2 + kstep;
            if (last && has_next) S.a_ready(nxt);
            if constexpr (SP2) {
            PG8_LDB(B0, 0, 0); PG8_LDB(B1, 0, 1); PG8_SCHED; PG8_LDA(At, 0, 0); PG8_STAGE(PG8_SA(1, 1), a1 + hstep, voffA);
            PG8_WAIT_V(8); PG8_WAIT_L(0); PG8_BAR; PG8_MMA(0, 0, At, B0); PG8_MMA(0, 1, At, B1); PG8_BAR; PG8_SCHED;
            PG8_LDA(At, 0, 1); PG8_STAGE(PG8_SB(0, 0), b2, voffB); PG8_STAGE(PG8_SB(0, 1), b2 + hstep, voffB); PG8_STAGE(PG8_SA(0, 0), a2, voffA);
            PG8_WAIT_V(8); PG8_WAIT_L(0); PG8_BAR; PG8_MMA(1, 0, At, B0); PG8_MMA(1, 1, At, B1); PG8_BAR; PG8_SCHED;
            PG8_LDB(B0, 1, 0); PG8_LDB(B1, 1, 1); PG8_SCHED; PG8_LDA(At, 1, 0); PG8_STAGE(PG8_SA(0, 1), a2 + hstep, voffA);
            PG8_WAIT_V(8); PG8_WAIT_L(0); PG8_BAR; PG8_MMA(0, 0, At, B0); PG8_MMA(0, 1, At, B1); PG8_BAR; PG8_SCHED;
            PG8_LDA(At, 1, 1); PG8_STAGE(PG8_SB(1, 0), b3, voffB); PG8_STAGE(PG8_SB(1, 1), b3 + hstep, voffB); PG8_STAGE(PG8_SA(1, 0), a3, voffA);
            PG8_WAIT_V(8); PG8_WAIT_L(0); PG8_BAR; PG8_MMA(1, 0, At, B0); PG8_MMA(1, 1, At, B1); PG8_BAR; PG8_SCHED;
            } else {
            PG8_LDB(B0, 0, 0); PG8_SCHED; PG8_LDA(At, 0, 0); PG8_STAGE(PG8_SA(1, 1), a1 + hstep, voffA);
            PG8_WAIT_L(8); PG8_BAR; PG8_WAIT_L(0); PG8_MMA(0, 0, At, B0); PG8_BAR; PG8_SCHED;
            PG8_LDB(B1, 0, 1); PG8_STAGE(PG8_SB(0, 0), b2, voffB);
            PG8_BAR; PG8_WAIT_L(0); PG8_MMA(0, 1, At, B1); PG8_BAR;
            PG8_LDA(At, 0, 1); PG8_STAGE(PG8_SA(0, 0), a2, voffA);
            PG8_BAR; PG8_WAIT_L(0); PG8_MMA(1, 0, At, B0); PG8_BAR; PG8_SCHED;
            PG8_STAGE(PG8_SB(0, 1), b2 + hstep, voffB);
            PG8_WAIT_V(6); PG8_BAR; PG8_MMA(1, 1, At, B1); PG8_BAR;
            PG8_LDB(B0, 1, 0); PG8_SCHED; PG8_LDA(At, 1, 0); PG8_STAGE(PG8_SA(0, 1), a2 + hstep, voffA);
            PG8_WAIT_L(8); PG8_BAR; PG8_WAIT_L(0); PG8_MMA(0, 0, At, B0); PG8_BAR; PG8_SCHED;
            PG8_LDB(B1, 1, 1); PG8_STAGE(PG8_SB(1, 0), b3, voffB);
            PG8_BAR; PG8_WAIT_L(0); PG8_MMA(0, 1, At, B1); PG8_BAR;
            PG8_LDA(At, 1, 1); PG8_STAGE(PG8_SA(1, 0), a3, voffA);
            PG8_BAR; PG8_WAIT_L(0); PG8_MMA(1, 0, At, B0); PG8_BAR; PG8_SCHED;
            PG8_STAGE(PG8_SB(1, 1), b3 + hstep, voffB);
            PG8_WAIT_V(6); PG8_BAR; PG8_MMA(1, 1, At, B1); PG8_BAR;
            }
        }
        if constexpr (ALIGN_EPI) { if (wr == 0) PG8_BAR; }
        if constexpr (!Epi::AFTER_DRAIN) { E(acc, cur, wr, wc, fr, fq); S.done(cur); }
        if (!has_next) break;
#pragma unroll
        for (int a = 0; a < 2; ++a)
#pragma unroll
            for (int b = 0; b < 2; ++b)
#pragma unroll
                for (int m = 0; m < 4; ++m)
#pragma unroll
                    for (int n = 0; n < 2; ++n) acc[a][b][m][n] = (f32x4){0.f, 0.f, 0.f, 0.f};
        cur = nxt; cA = nA; cB = nB; ++ui;
        if constexpr (ALIGN_EPI) { if (wr == 1) PG8_BAR; }
    }
    PG8_WAIT_V(0);
    if constexpr (!ALIGN_EPI) { if (wr == 0) PG8_BAR; }
    PG8_BAR;
    if constexpr (Epi::AFTER_DRAIN) { E.fused(acc, cur, wr, wc, fr, fq, lds, wid, lane); S.done(cur); }
#undef PG8_SA
#undef PG8_SB
#undef PG8_STAGE
#undef PG8_LDA
#undef PG8_LDB
#undef PG8_MMA
#undef PG8_WAIT_V
#undef PG8_WAIT_L
#undef PG8_BAR
#undef PG8_SCHED
}
}
namespace cg = cooperative_groups;
#define LAS __attribute__((address_space(3)))
typedef unsigned short bf16_t;
typedef short bf16x8 __attribute__((ext_vector_type(8)));
typedef float f32x4 __attribute__((ext_vector_type(4)));
typedef unsigned u32x4 __attribute__((ext_vector_type(4)));
typedef unsigned u32x2 __attribute__((ext_vector_type(2)));
typedef __bf16 bf16x2_n __attribute__((ext_vector_type(2)));
typedef float f32x2 __attribute__((ext_vector_type(2)));

constexpr int T = 16384, SEQ = 2048, D = 2048, FF = 5632, NGU = 2 * FF, NIN = 4608, QD = 1024, DEPTH = 2;
constexpr int ZP = FF;
constexpr float EPS = 1e-6f;
constexpr int NTHREADS = 512, NWAVES = 8;
constexpr int LDS_BYTES = 144 * 1024;
constexpr size_t SZ_GU = (size_t)NGU * D * 2, SZ_DN = (size_t)D * FF * 2, SZ_IN = (size_t)NIN * D * 2, SZ_OUT = (size_t)D * D * 2;
constexpr size_t OFF_GU1 = 0, OFF_D1 = OFF_GU1 + SZ_GU, OFF_IN = OFF_D1 + SZ_DN, OFF_OUT = OFF_IN + SZ_IN, OFF_GU2 = OFF_OUT + SZ_OUT, OFF_D2 = OFF_GU2 + SZ_GU, SZ_LAYER = OFF_D2 + SZ_DN;
constexpr size_t WS_W = 0, WS_XN = WS_W + DEPTH * SZ_LAYER, WS_BIG = WS_XN + (size_t)T * D * 2, WS_HF = WS_BIG + (size_t)T * FF * 2, WS_CTL = WS_HF + (size_t)T * D * 4, WS_LSE = WS_CTL + 32768, WS_RS = WS_LSE + (size_t)3 * T * 8 * 4, WS_LO = WS_RS + (size_t)T * 4, WS_END = WS_LO + (size_t)T * D * 2;
constexpr size_t OB_STRIDE = (size_t)T * QD;
constexpr size_t LSE_OFF = 3 * OB_STRIDE * 2;

struct Params { const float* in[16]; float* out; unsigned char* ws; };

__device__ __forceinline__ float wave_sum(float v) {
#pragma unroll
    for (int o = 1; o < 64; o <<= 1) v += __shfl_xor(v, o);
    return v;
}
__device__ __forceinline__ unsigned pk2(float lo, float hi) {
    const bf16x2_n r = __builtin_convertvector((f32x2){lo, hi}, bf16x2_n);
    return __builtin_bit_cast(unsigned, r);
}
__device__ __forceinline__ float bflo(unsigned w) { return __uint_as_float(w << 16); }
__device__ __forceinline__ float bfhi(unsigned w) { return __uint_as_float(w & 0xffff0000u); }
__device__ __forceinline__ float dot4(f32x4 a) { return (a.x * a.x + a.y * a.y) + (a.z * a.z + a.w * a.w); }

__device__ __forceinline__ void transpose_item(const float* W, int K, int N, bf16_t* WT, bool gu, LAS unsigned* scr, int item, int lane) {
    const int nblk = N / 64, kb = item / nblk, nb = item - kb * nblk, k0 = 64 * kb, n0 = 64 * nb;
    const int n4 = lane & 15, kq = lane >> 4;
    const float* src = W + (size_t)(k0 + 2 * kq) * N + n0 + 4 * n4;
    f32x4 L0[8], L1[8];
#pragma unroll
    for (int i = 0; i < 8; ++i) { L0[i] = *(const f32x4*)(src + (size_t)(8 * i) * N); L1[i] = *(const f32x4*)(src + (size_t)(8 * i + 1) * N); }
#pragma unroll
    for (int i = 0; i < 8; ++i) { const int kp = 4 * i + kq;
#pragma unroll
        for (int j = 0; j < 4; ++j) scr[(4 * n4 + j) * 33 + kp] = pk2(L0[i][j], L1[i][j]); }
    asm volatile("s_waitcnt lgkmcnt(0)" ::: "memory");
    int row0 = n0;
    if (gu) { const int up = n0 >= FF, nn = up ? n0 - FF : n0; row0 = 256 * (nn >> 7) + (up ? 128 : 0) + (nn & 127); }
    const int c = lane & 7;
#pragma unroll
    for (int j = 0; j < 8; ++j) { const int n = (lane >> 3) + 8 * j; const LAS unsigned* s = scr + n * 33 + 4 * c;
        u32x4 o; o.x = s[0]; o.y = s[1]; o.z = s[2]; o.w = s[3];
        *(u32x4*)(WT + (size_t)(row0 + n) * K + k0 + 8 * c) = o; }
    asm volatile("s_waitcnt lgkmcnt(0)" ::: "memory");
}
constexpr int IT_GU = (D / 64) * (NGU / 64), IT_DN = (FF / 64) * (D / 64), IT_IN = (D / 64) * (NIN / 64), IT_OUT = (D / 64) * (D / 64);
constexpr int IT_LAYER = 2 * IT_GU + 2 * IT_DN + IT_IN + IT_OUT;

__device__ __forceinline__ void prologue_phase(const Params& p, LAS unsigned char* lds, int gw, int ngw, int wave, int lane) {
    LAS unsigned* scr = (LAS unsigned*)(lds + wave * 16384);
    unsigned char* wsw = p.ws + WS_W;
    for (int it = gw; it < DEPTH * IT_LAYER; it += ngw) {
        const int l = it / IT_LAYER; int r = it - l * IT_LAYER;
        unsigned char* wl = wsw + (size_t)l * SZ_LAYER;
        if (r < IT_GU) { transpose_item(p.in[2] + (size_t)l * D * NGU, D, NGU, (bf16_t*)(wl + OFF_GU1), true, scr, r, lane); continue; } r -= IT_GU;
        if (r < IT_DN) { transpose_item(p.in[3] + (size_t)l * FF * D, FF, D, (bf16_t*)(wl + OFF_D1), false, scr, r, lane); continue; } r -= IT_DN;
        if (r < IT_IN) { transpose_item(p.in[6] + (size_t)l * D * NIN, D, NIN, (bf16_t*)(wl + OFF_IN), false, scr, r, lane); continue; } r -= IT_IN;
        if (r < IT_OUT) { transpose_item(p.in[10] + (size_t)l * D * D, D, D, (bf16_t*)(wl + OFF_OUT), false, scr, r, lane); continue; } r -= IT_OUT;
        if (r < IT_GU) { transpose_item(p.in[13] + (size_t)l * D * NGU, D, NGU, (bf16_t*)(wl + OFF_GU2), true, scr, r, lane); continue; } r -= IT_GU;
        transpose_item(p.in[14] + (size_t)l * FF * D, FF, D, (bf16_t*)(wl + OFF_D2), false, scr, r, lane);
    }
    const float* x = p.in[0]; const f32x4* g4 = (const f32x4*)p.in[1]; bf16_t* XN = (bf16_t*)(p.ws + WS_XN);
    for (int row = gw; row < T; row += ngw) {
        const f32x4* xr = (const f32x4*)(x + (size_t)row * D) + lane; f32x4 v[8]; float ss = 0.f;
#pragma unroll
        for (int j = 0; j < 8; ++j) { v[j] = xr[64 * j]; ss += dot4(v[j]); }
        const float rs = rsqrtf(wave_sum(ss) * (1.f / D) + EPS);
        u32x2* o = (u32x2*)(XN + (size_t)row * D) + lane;
#pragma unroll
        for (int j = 0; j < 8; ++j) { const f32x4 y = v[j] * rs * g4[lane + 64 * j]; o[64 * j] = (u32x2){pk2(y.x, y.y), pk2(y.z, y.w)}; }
    }
}

__device__ __forceinline__ f32x4 bf4lo(u32x4 w) { return (f32x4){bflo(w.x), bfhi(w.x), bflo(w.y), bfhi(w.y)}; }
__device__ __forceinline__ f32x4 bf4hi(u32x4 w) { return (f32x4){bflo(w.z), bfhi(w.z), bflo(w.w), bfhi(w.w)}; }
__device__ __forceinline__ f32x4 rcp4(f32x4 g) { return (f32x4){__builtin_amdgcn_rcpf(g.x), __builtin_amdgcn_rcpf(g.y), __builtin_amdgcn_rcpf(g.z), __builtin_amdgcn_rcpf(g.w)}; }
__device__ __forceinline__ void normres_phase(const bf16_t* hf, const float* xsrc, const float* gprev, bf16_t* HI, bf16_t* LO, float* RS, float* xdst, const float* gpost, float w, const float* gpre,
                                              int row0, int rstride, int nrows, unsigned* ctr, int poolbase, int npool, int lane) {
    const int nstat = (nrows + 1) >> 1; unsigned vnext = 0u;
    for (int trip = 0; ; ++trip) {
        int row, rowb; bool two;
        if (trip < nstat) {
            row = row0 + 2 * trip * rstride; if (row >= T) break;
            two = (2 * trip + 1 < nrows) && (row + rstride < T); rowb = two ? row + rstride : row;
            if (ctr != nullptr && trip == nstat - 1 && lane == 0) vnext = __hip_atomic_fetch_add(ctr, 1u, __ATOMIC_RELAXED, __HIP_MEMORY_SCOPE_AGENT);
        } else {
            if (ctr == nullptr) break;
            const unsigned pcur = (unsigned)__builtin_amdgcn_readfirstlane((int)vnext); if (pcur >= (unsigned)npool) break;
            row = poolbase + 2 * (int)pcur; rowb = row + 1; two = true;
            if (lane == 0) vnext = __hip_atomic_fetch_add(ctr, 1u, __ATOMIC_RELAXED, __HIP_MEMORY_SCOPE_AGENT);
        }
        u32x4 hw[2][4]; f32x4 xv[2][8];
        if (xsrc) {
#pragma unroll
            for (int q = 0; q < 2; ++q) { const int rr = q ? rowb : row;
                const u32x4* hr = (const u32x4*)(hf + (size_t)rr * D) + lane; const f32x4* xr = (const f32x4*)(xsrc + (size_t)rr * D) + 2 * lane;
#pragma unroll
                for (int c = 0; c < 4; ++c) { hw[q][c] = hr[64 * c]; xv[q][2 * c] = xr[128 * c]; xv[q][2 * c + 1] = xr[128 * c + 1]; } }
        } else {
            u32x4 hiw[2][4]; float rsp[2];
#pragma unroll
            for (int q = 0; q < 2; ++q) { const int rr = q ? rowb : row;
                const u32x4* hr = (const u32x4*)(hf + (size_t)rr * D) + lane; const u32x4* ar = (const u32x4*)(HI + (size_t)rr * D) + lane;
                rsp[q] = RS[rr];
#pragma unroll
                for (int c = 0; c < 4; ++c) { hw[q][c] = hr[64 * c]; hiw[q][c] = ar[64 * c]; } }
            const f32x4* gv4 = (const f32x4*)gprev + 2 * lane;
#pragma unroll
            for (int c = 0; c < 4; ++c) { const f32x4 ig0 = rcp4(gv4[128 * c]), ig1 = rcp4(gv4[128 * c + 1]);
#pragma unroll
                for (int q = 0; q < 2; ++q) { const float inv = __builtin_amdgcn_rcpf(rsp[q]);
                    xv[q][2 * c] = bf4lo(hiw[q][c]) * ig0 * inv; xv[q][2 * c + 1] = bf4hi(hiw[q][c]) * ig1 * inv; } }
        }
#pragma unroll
        for (int q = 0; q < 2; ++q) { if (q == 1 && !two) break; const int rr = q ? rowb : row;
            float ss = 0.f;
#pragma unroll
            for (int c = 0; c < 4; ++c) ss += dot4(bf4lo(hw[q][c])) + dot4(bf4hi(hw[q][c]));
            const float rs = rsqrtf(wave_sum(ss) * (1.f / D) + EPS) * w; float ss2 = 0.f;
            const f32x4* gp4 = (const f32x4*)gpost + 2 * lane;
#pragma unroll
            for (int c = 0; c < 4; ++c) { xv[q][2 * c] = xv[q][2 * c] + bf4lo(hw[q][c]) * rs * gp4[128 * c]; xv[q][2 * c + 1] = xv[q][2 * c + 1] + bf4hi(hw[q][c]) * rs * gp4[128 * c + 1];
                ss2 += dot4(xv[q][2 * c]) + dot4(xv[q][2 * c + 1]); }
            if (xdst) {
                f32x4* xo = (f32x4*)(xdst + (size_t)rr * D) + 2 * lane;
#pragma unroll
                for (int c = 0; c < 4; ++c) { xo[128 * c] = xv[q][2 * c]; xo[128 * c + 1] = xv[q][2 * c + 1]; }
            } else {
                const float rs2 = rsqrtf(wave_sum(ss2) * (1.f / D) + EPS);
                const f32x4* gn4 = (const f32x4*)gpre + 2 * lane; u32x4* oh = (u32x4*)(HI + (size_t)rr * D) + lane;
#pragma unroll
                for (int c = 0; c < 4; ++c) { const f32x4 y0 = xv[q][2 * c] * rs2 * gn4[128 * c], y1 = xv[q][2 * c + 1] * rs2 * gn4[128 * c + 1];
                    oh[64 * c] = (u32x4){pk2(y0.x, y0.y), pk2(y0.z, y0.w), pk2(y1.x, y1.y), pk2(y1.z, y1.w)}; }
                if (lane == 0) RS[rr] = rs2;
            }
        }
    }
}

constexpr int KS_STRIDE = 272, VT_STRIDE = 528, VT_OFF = 256 * KS_STRIDE;
static_assert(VT_OFF + 128 * VT_STRIDE <= LDS_BYTES, "attention LDS");
#define MFMA16(a, b, c) __builtin_amdgcn_mfma_f32_16x16x32_bf16((a), (b), (c), 0, 0, 0)
__device__ __forceinline__ void attn_phase(LAS unsigned char* lds, bf16_t* Z, bf16_t* OB12, float* LSE, int it0, int itstride, int nit, int tid) {
    const int wid = __builtin_amdgcn_readfirstlane(tid >> 6), lane = tid & 63, l15 = lane & 15, quad = lane >> 4;
    for (int ki = 0, it = it0; ki < nit && it < 768; ++ki, it += itstride) {
        const int sub = it & 15, br = (it >> 4) % 3, bg = it / 48, g = bg & 1, b = bg >> 1;
        int d, n, e; if (br == 0) { d = 1; n = sub; e = 0; } else if (br == 1) { d = 4; n = sub >> 2; e = sub & 3; } else { d = 16; n = 0; e = sub; }
        __syncthreads();
        {
            const int kp = tid >> 2, qtr = tid & 3, kj0 = 2 * kp;
            const bool valid = (n > 0) || (kj0 >= 128);
            u32x4 k0[4], k1[4], v0[4], v1[4];
            if (valid) {
                const int p0 = ((n - 1) * 128 + kj0) * d + e;
                const bf16_t* r0 = Z + (size_t)(b * SEQ + p0) * ZP + g * 128 + qtr * 32; const bf16_t* r1 = r0 + (size_t)d * ZP;
#pragma unroll
                for (int i = 0; i < 4; ++i) { k0[i] = *(const u32x4*)(r0 + 1024 + 8 * i); k1[i] = *(const u32x4*)(r1 + 1024 + 8 * i); v0[i] = *(const u32x4*)(r0 + 1280 + 8 * i); v1[i] = *(const u32x4*)(r1 + 1280 + 8 * i); }
            } else {
#pragma unroll
                for (int i = 0; i < 4; ++i) { k0[i] = (u32x4){0u, 0u, 0u, 0u}; k1[i] = k0[i]; v0[i] = k0[i]; v1[i] = k0[i]; }
            }
#pragma unroll
            for (int i = 0; i < 4; ++i) {
                *(LAS u32x4*)(lds + kj0 * KS_STRIDE + (qtr * 32 + 8 * i) * 2) = k0[i];
                *(LAS u32x4*)(lds + (kj0 + 1) * KS_STRIDE + (qtr * 32 + 8 * i) * 2) = k1[i];
#pragma unroll
                for (int w = 0; w < 4; ++w) { const unsigned a = v0[i][w], c = v1[i][w]; const int hd = qtr * 32 + 8 * i + 2 * w;
                    *(LAS unsigned*)(lds + VT_OFF + hd * VT_STRIDE + kj0 * 2) = (a & 0xffffu) | (c << 16);
                    *(LAS unsigned*)(lds + VT_OFF + (hd + 1) * VT_STRIDE + kj0 * 2) = (a >> 16) | (c & 0xffff0000u); }
            }
        }
        __syncthreads();
#pragma unroll 1
        for (int pass = 0; pass < 2; ++pass) {
            const int task = wid + 8 * pass, r = task & 3, c = task >> 2, head = g * 4 + r;
            const int kt0 = (n == 0) ? (8 - 2 * c) : 0;
            bf16x8 qf[2][4];
#pragma unroll
            for (int qt = 0; qt < 2; ++qt) { const int i = 32 * c + 16 * qt + l15; const size_t tok = (size_t)b * SEQ + (size_t)((n * 128 + i) * d + e);
                const bf16_t* qr = Z + tok * ZP + head * 128 + quad * 8;
#pragma unroll
                for (int ks = 0; ks < 4; ++ks) qf[qt][ks] = *(const bf16x8*)(qr + ks * 32); }
            f32x4 sacc[10][2];
#pragma unroll
            for (int kt = 0; kt < 10; ++kt) { sacc[kt][0] = (f32x4){0.f, 0.f, 0.f, 0.f}; sacc[kt][1] = sacc[kt][0]; }
#pragma unroll
            for (int kt = 0; kt < 10; ++kt) if (kt >= kt0) {
#pragma unroll
                for (int ks = 0; ks < 4; ++ks) { const bf16x8 kf = *(const LAS bf16x8*)(lds + (32 * c + 16 * kt + l15) * KS_STRIDE + (ks * 32 + quad * 8) * 2);
                    sacc[kt][0] = MFMA16(kf, qf[0][ks], sacc[kt][0]); sacc[kt][1] = MFMA16(kf, qf[1][ks], sacc[kt][1]); }
            }
            const float SC = 0.08838834764831845f * 1.4426950408889634f;
            float mrow[2], lrow[2];
#pragma unroll
            for (int qt = 0; qt < 2; ++qt) { const int i = 32 * c + 16 * qt + l15; float mx = -__builtin_inff();
#pragma unroll
                for (int kt = 0; kt < 10; ++kt)
#pragma unroll
                    for (int j = 0; j < 4; ++j) { const int kj = 32 * c + 16 * kt + 4 * quad + j; const bool ok = (kj >= i) && (kj <= i + 128) && (n > 0 || kj >= 128);
                        const float s = ok ? sacc[kt][qt][j] * SC : -__builtin_inff(); sacc[kt][qt][j] = s; mx = fmaxf(mx, s); }
                mx = fmaxf(mx, __shfl_xor(mx, 16)); mx = fmaxf(mx, __shfl_xor(mx, 32));
                float l = 0.f;
#pragma unroll
                for (int kt = 0; kt < 10; ++kt)
#pragma unroll
                    for (int j = 0; j < 4; ++j) { const float pv = __builtin_amdgcn_exp2f(sacc[kt][qt][j] - mx); sacc[kt][qt][j] = pv; l += pv; }
                l += __shfl_xor(l, 16); l += __shfl_xor(l, 32);
                mrow[qt] = mx; lrow[qt] = l; }
            bf16x8 pf[5][2];
#pragma unroll
            for (int kp = 0; kp < 5; ++kp)
#pragma unroll
                for (int qt = 0; qt < 2; ++qt) { const f32x4 a = sacc[2 * kp][qt], c2 = sacc[2 * kp + 1][qt];
                    const u32x4 w = (u32x4){pk2(a[0], a[1]), pk2(a[2], a[3]), pk2(c2[0], c2[1]), pk2(c2[2], c2[3])}; pf[kp][qt] = __builtin_bit_cast(bf16x8, w); }
            f32x4 oacc[8][2];
#pragma unroll
            for (int ht = 0; ht < 8; ++ht) { oacc[ht][0] = (f32x4){0.f, 0.f, 0.f, 0.f}; oacc[ht][1] = oacc[ht][0]; }
#pragma unroll
            for (int kp = 0; kp < 5; ++kp) if (2 * kp >= kt0) {
#pragma unroll
                for (int ht = 0; ht < 8; ++ht) { const LAS unsigned char* vp = lds + VT_OFF + (16 * ht + l15) * VT_STRIDE + (32 * c + 32 * kp + 4 * quad) * 2;
                    const u32x2 lo = *(const LAS u32x2*)vp, hi = *(const LAS u32x2*)(vp + 32);
                    const bf16x8 vf = __builtin_bit_cast(bf16x8, ((u32x4){lo.x, lo.y, hi.x, hi.y}));
                    oacc[ht][0] = MFMA16(vf, pf[kp][0], oacc[ht][0]); oacc[ht][1] = MFMA16(vf, pf[kp][1], oacc[ht][1]); }
            }
#pragma unroll
            for (int qt = 0; qt < 2; ++qt) { const int i = 32 * c + 16 * qt + l15; const size_t tok = (size_t)b * SEQ + (size_t)((n * 128 + i) * d + e);
                const float inv = 1.0f / lrow[qt];
                bf16_t* op = (br == 0 ? Z + tok * ZP + NIN : OB12 + (size_t)b * SEQ * D + (size_t)(br - 1) * SEQ * QD + (tok - (size_t)b * SEQ) * QD) + head * 128 + 4 * quad;
#pragma unroll
                for (int ht = 0; ht < 8; ++ht) { const f32x4 o = oacc[ht][qt] * inv; *(u32x2*)(op + 16 * ht) = (u32x2){pk2(o.x, o.y), pk2(o.z, o.w)}; }
                if (quad == 0) LSE[((size_t)br * T + tok) * 8 + head] = mrow[qt] * 0.6931471805599453f + __logf(lrow[qt]); }
        }
    }
}

__device__ __forceinline__ void combine_phase(const bf16_t* Z, const bf16_t* OB12, const float* LSE, const float* convw, const float* ga, const float* gc, bf16_t* XN, int boff, int row0, int rstride, int nrows, int lane) {
    for (int kr = 0, t = row0; kr < nrows && t < T; ++kr, t += rstride) {
        const int s = t & (SEQ - 1);
        float av[2][8], cv[2][8]; float ssa = 0.f, ssc = 0.f;
#pragma unroll
        for (int j = 0; j < 2; ++j) { const int chunk = lane + 64 * j, col = chunk * 8, head = chunk >> 4;
            const float l0 = LSE[((size_t)0 * T + t) * 8 + head], l1 = LSE[((size_t)1 * T + t) * 8 + head], l2 = LSE[((size_t)2 * T + t) * 8 + head];
            const float mx = fmaxf(l0, fmaxf(l1, l2)); float w0 = __expf(l0 - mx), w1 = __expf(l1 - mx), w2 = __expf(l2 - mx); const float inv = 1.0f / (w0 + w1 + w2); w0 *= inv; w1 *= inv; w2 *= inv;
            const u32x4 o0 = *(const u32x4*)(Z + (size_t)t * ZP + NIN + col), o1 = *(const u32x4*)(OB12 + (size_t)(t >> 11) * SEQ * D + (size_t)s * QD + col), o2 = *(const u32x4*)(OB12 + (size_t)(t >> 11) * SEQ * D + (size_t)SEQ * QD + (size_t)s * QD + col);
#pragma unroll
            for (int w = 0; w < 4; ++w) { const float a0 = w0 * bflo(o0[w]) + w1 * bflo(o1[w]) + w2 * bflo(o2[w]), a1 = w0 * bfhi(o0[w]) + w1 * bfhi(o1[w]) + w2 * bfhi(o2[w]);
                av[j][2 * w] = a0; av[j][2 * w + 1] = a1; ssa += a0 * a0 + a1 * a1; } }
#pragma unroll
        for (int j = 0; j < 2; ++j) { const int ch = (lane + 64 * j) * 8; const bf16_t* zr = Z + (size_t)t * ZP;
            const u32x4 hc0 = *(const u32x4*)(zr + 1536 + ch), bg0 = *(const u32x4*)(zr + 2560 + ch), cg0 = *(const u32x4*)(zr + 3584 + ch);
            u32x4 hc1 = (u32x4){0u, 0u, 0u, 0u}, cg1 = hc1, hc2 = hc1, cg2 = hc1;
            if (s >= 1) { hc1 = *(const u32x4*)(zr - ZP + 1536 + ch); cg1 = *(const u32x4*)(zr - ZP + 3584 + ch); }
            if (s >= 2) { hc2 = *(const u32x4*)(zr - 2 * ZP + 1536 + ch); cg2 = *(const u32x4*)(zr - 2 * ZP + 3584 + ch); }
            float wk[3][8];
#pragma unroll
            for (int k = 0; k < 3; ++k) { const f32x4 a = *(const f32x4*)(convw + k * QD + ch), b2 = *(const f32x4*)(convw + k * QD + ch + 4);
                wk[k][0] = a.x; wk[k][1] = a.y; wk[k][2] = a.z; wk[k][3] = a.w; wk[k][4] = b2.x; wk[k][5] = b2.y; wk[k][6] = b2.z; wk[k][7] = b2.w; }
#pragma unroll
            for (int w = 0; w < 4; ++w) {
                const float y0 = wk[2][2 * w] * (bflo(cg0[w]) * bflo(hc0[w])) + wk[1][2 * w] * (bflo(cg1[w]) * bflo(hc1[w])) + wk[0][2 * w] * (bflo(cg2[w]) * bflo(hc2[w]));
                const float y1 = wk[2][2 * w + 1] * (bfhi(cg0[w]) * bfhi(hc0[w])) + wk[1][2 * w + 1] * (bfhi(cg1[w]) * bfhi(hc1[w])) + wk[0][2 * w + 1] * (bfhi(cg2[w]) * bfhi(hc2[w]));
                const float c0 = bflo(bg0[w]) * y0, c1 = bfhi(bg0[w]) * y1; cv[j][2 * w] = c0; cv[j][2 * w + 1] = c1; ssc += c0 * c0 + c1 * c1; } }
        const float ra = rsqrtf(wave_sum(ssa) * (1.f / QD) + EPS), rc = rsqrtf(wave_sum(ssc) * (1.f / QD) + EPS);
#pragma unroll
        for (int j = 0; j < 2; ++j) { const int col = (lane + 64 * j) * 8;
            const f32x4 g0 = *(const f32x4*)(ga + col), g1 = *(const f32x4*)(ga + col + 4), h0 = *(const f32x4*)(gc + col), h1 = *(const f32x4*)(gc + col + 4);
            u32x4 oa, oc;
            oa.x = pk2(av[j][0] * ra * g0.x, av[j][1] * ra * g0.y); oa.y = pk2(av[j][2] * ra * g0.z, av[j][3] * ra * g0.w); oa.z = pk2(av[j][4] * ra * g1.x, av[j][5] * ra * g1.y); oa.w = pk2(av[j][6] * ra * g1.z, av[j][7] * ra * g1.w);
            oc.x = pk2(cv[j][0] * rc * h0.x, cv[j][1] * rc * h0.y); oc.y = pk2(cv[j][2] * rc * h0.z, cv[j][3] * rc * h0.w); oc.z = pk2(cv[j][4] * rc * h1.x, cv[j][5] * rc * h1.y); oc.w = pk2(cv[j][6] * rc * h1.z, cv[j][7] * rc * h1.w);
            bf16_t* xo = XN + (size_t)t * D + (size_t)(t >> 11) * boff;
            *(u32x4*)(xo + col) = oa; *(u32x4*)(xo + QD + col) = oc; }
    }
}

#define XB_TMO      128
#define XB_XCNT(j)  (256  + 64 * (j))
#define XB_XSUB(j)  (1280 + 64 * (j))
#define XB_XGEN(j)  (2304 + 64 * (j))
#define XB_TOP      3328
#define XB_TOPGEN   3392
#define XCD_BAR_WORDS 3456
#define XB_SPIN_CAP (1u << 18)
__device__ __forceinline__ unsigned xb_ld(unsigned* p)              { return __hip_atomic_load(p, __ATOMIC_RELAXED, __HIP_MEMORY_SCOPE_AGENT); }
__device__ __forceinline__ unsigned xb_add(unsigned* p, unsigned v) { return __hip_atomic_fetch_add(p, v, __ATOMIC_RELAXED, __HIP_MEMORY_SCOPE_AGENT); }
__device__ __forceinline__ unsigned xb_xcc_id() { return (unsigned)__builtin_amdgcn_s_getreg((3 << 11) | 20) & 0xFu; }
#define XB_SPIN(cond, bar) do { unsigned _sp = 0; while (cond) { __builtin_amdgcn_s_sleep(1); \
    if ((++_sp & 255u) == 0u) { if (xb_ld(&(bar)[XB_TMO])) break; if (_sp > XB_SPIN_CAP) { atomicAdd(&(bar)[XB_TMO], 1u); break; } } } } while (0)
__device__ __forceinline__ void xcd_barrier_complete(unsigned* bar, unsigned x, unsigned& nloc, unsigned& nx) {
    const unsigned G = gridDim.x * gridDim.y * gridDim.z;
    unsigned sum, cnt, mine, sp = 0u;
    for (;;) {
        sum = 0u; cnt = 0u; mine = 0u;
#pragma unroll
        for (unsigned j = 0; j < 16; ++j) { const unsigned c = xb_ld(&bar[XB_XCNT(j)]); sum += c; cnt += (c > 0u) ? 1u : 0u; mine = (j == x) ? c : mine; }
        if (sum == G) break;
        __builtin_amdgcn_s_sleep(1);
        if ((++sp & 255u) == 0u) { if (xb_ld(&bar[XB_TMO])) break; if (sp > XB_SPIN_CAP) { atomicAdd(&bar[XB_TMO], 1u); break; } }
    }
    nloc = mine > 0u ? mine : 1u; nx = cnt > 0u ? cnt : 1u;
}
__device__ __forceinline__ void xcd_barrier(unsigned* bar, volatile LAS unsigned* st, int tid) {
    asm volatile("s_waitcnt vmcnt(0)" ::: "memory");
    __syncthreads();
    if (tid == 0) {
        const unsigned x = xb_xcc_id();
        __builtin_amdgcn_s_waitcnt(0);
        unsigned nloc = st[0], nx = st[1];
        if (nloc == 0u) { xcd_barrier_complete(bar, x, nloc, nx); st[0] = nloc; st[1] = nx; }
        const unsigned old = xb_add(&bar[XB_XSUB(x)], 1u);
        const unsigned gen = old / nloc;
        if (old + 1u == (gen + 1u) * nloc) {
            __builtin_amdgcn_fence(__ATOMIC_RELEASE, "agent");
            asm volatile("s_waitcnt vmcnt(0)" ::: "memory");
            const unsigned og = xb_add(&bar[XB_TOP], 1u);
            const unsigned tg = og / nx;
            if (og + 1u == (tg + 1u) * nx) xb_add(&bar[XB_TOPGEN], 1u);
            else XB_SPIN(xb_ld(&bar[XB_TOPGEN]) == tg, bar);
            __builtin_amdgcn_fence(__ATOMIC_ACQUIRE, "agent");
            xb_add(&bar[XB_XGEN(x)], 1u);
            asm volatile("s_waitcnt vmcnt(0)" ::: "memory");
        } else {
            XB_SPIN(xb_ld(&bar[XB_XGEN(x)]) == gen, bar);
            __builtin_amdgcn_fence(__ATOMIC_ACQUIRE, "agent");
            asm volatile("s_waitcnt vmcnt(0)" ::: "memory");
        }
    }
    __syncthreads();
}
#define XL_WORD(x) (4096 + 64 * (x))
__device__ __forceinline__ void xcc_local_barrier(unsigned* cnt, unsigned target, int tid) {
    asm volatile("s_waitcnt vmcnt(0)" ::: "memory");
    __syncthreads();
    if (tid == 0) {
        __builtin_amdgcn_s_waitcnt(0);
        (void)xb_add(cnt, 1u);
        unsigned sp = 0u;
        while (xb_ld(cnt) < target) { __builtin_amdgcn_s_sleep(1); if (++sp > (1u << 24)) break; }
        __builtin_amdgcn_fence(__ATOMIC_ACQUIRE, "agent");
        asm volatile("s_waitcnt vmcnt(0)" ::: "memory");
    }
    __syncthreads();
}
struct Ctx { int tid, lane, wave, G, bid, gw, ngw; };
__device__ __forceinline__ int make_tid(int wave_s) {
    int ln; asm volatile("v_mbcnt_lo_u32_b32 %0, -1, 0\n\tv_mbcnt_hi_u32_b32 %0, -1, %0" : "=&v"(ln));
    return wave_s * 64 + ln;
}
__device__ __forceinline__ Ctx make_ctx(int wave_s) {
    const int t = make_tid(wave_s);
    Ctx c; c.tid = t; c.lane = t & 63; c.wave = wave_s; c.G = gridDim.x; c.bid = blockIdx.x; c.gw = c.bid * NWAVES + c.wave; c.ngw = c.G * NWAVES; return c;
}
__device__ __forceinline__ const Params* get_params() {
    const Params* pp = (const Params*)__builtin_amdgcn_kernarg_segment_ptr(); asm volatile("" : "+s"(pp)); return pp;
}
__global__ void __launch_bounds__(NTHREADS) fwd_megakernel(Params p_unused) {
    extern __shared__ __attribute__((aligned(16))) unsigned char lds_raw[];
    LAS unsigned char* lds = (LAS unsigned char*)lds_raw;
    cg::grid_group grid = cg::this_grid();
    const int wave_s = __builtin_amdgcn_readfirstlane((int)threadIdx.x >> 6);
    volatile LAS unsigned* xst = (volatile LAS unsigned*)(lds + LDS_BYTES - 16);
    { unsigned* barp = (unsigned*)(get_params()->ws + WS_CTL); const unsigned xcc = xb_xcc_id();
      if (threadIdx.x == 0) { xst[0] = 0u; xst[1] = 0u; xst[2] = xb_add(&barp[XB_XCNT(xcc)], 1u); } }
    { const Params* pp = get_params(); const Ctx c = make_ctx(wave_s); prologue_phase(*pp, lds, c.gw, c.ngw, c.wave, c.lane); }
    __syncthreads();
    grid.sync();
    { unsigned* barp = (unsigned*)(get_params()->ws + WS_CTL);
      if (threadIdx.x == 0) { bool even = (gridDim.x == 256);
          for (unsigned j = 0; j < 16; ++j) { const unsigned cn = xb_ld(&barp[XB_XCNT(j)]); even = even && (j < 8 ? cn == 32u : cn == 0u); }
          xst[3] = even ? 1u : 0u; } }
    __syncthreads();
    const unsigned xcc_s = xb_xcc_id();
    const bool xlocal = __builtin_amdgcn_readfirstlane((int)xst[3]) != 0;
    const int vbid = xlocal ? (int)(__builtin_amdgcn_readfirstlane((int)xst[2]) * 8 + (int)xcc_s) : (int)blockIdx.x;
    const bool grouped = (gridDim.x == 256);
    const int vb_b = vbid & 7, vb_r = vbid >> 3;
    unsigned lk = 0u;
#define GRID_BAR() do { if (xlocal) { ++lk; xcc_local_barrier((unsigned*)(get_params()->ws + WS_CTL) + XL_WORD(xcc_s), 32u * lk, make_tid(wave_s)); } \
                        else xcd_barrier((unsigned*)(get_params()->ws + WS_CTL), xst, make_tid(wave_s)); } while (0)
#define ROW0(c) (grouped ? vb_b * SEQ + vb_r * 8 + (c).wave : (c).gw)
#define RSTRIDE(c) (grouped ? 256 : (c).ngw)
#define NROWS() (grouped ? 8 : T)
    unsigned nri = 0u;
#define DYN_WORD(i, b) (5120 + 16 * ((int)(i) * 8 + (b)))
#define NR_ARGS(c) ROW0(c), RSTRIDE(c), (grouped ? 6 : T), (grouped ? (unsigned*)(ws + WS_CTL) + DYN_WORD(nri, vb_b) : nullptr), vb_b * SEQ + 1536, 256, (c).lane
#pragma unroll 1
    for (int l = 0; l < DEPTH; ++l) {
#pragma unroll 1
        for (int f = 0; f < 2; ++f) {
            if (f == 1) {
                { const Params* pp = get_params(); unsigned char* ws = pp->ws; const int G = gridDim.x, bid = vbid;
                  pg8::Gemm g{(const bf16_t*)(ws + WS_XN), (const bf16_t*)(ws + WS_W + (size_t)l * SZ_LAYER + OFF_IN), T, NIN, D}; pg8::StaticOrder S; S.init(T, NIN, G, bid); pg8::EpiBf16 E{(bf16_t*)(ws + WS_BIG), ZP};
                  pg8::gemm_phase<pg8::EpiBf16, pg8::StaticOrder, true, true>(lds, g, S, E, make_tid(wave_s)); }
                GRID_BAR();
                { const Params* pp = get_params(); unsigned char* ws = pp->ws; const Ctx c = make_ctx(wave_s);
                  attn_phase(lds, (bf16_t*)(ws + WS_BIG), (bf16_t*)(ws + WS_HF + (size_t)T * D * 2), (float*)(ws + WS_LSE), grouped ? (vb_b * 2 + (vb_r & 1)) * 48 + (vb_r >> 1) : c.bid, grouped ? 16 : c.G, grouped ? 3 : 768, c.tid); }
                GRID_BAR();
                { const Params* pp = get_params(); unsigned char* ws = pp->ws; const Ctx c = make_ctx(wave_s);
                  combine_phase((const bf16_t*)(ws + WS_BIG), (const bf16_t*)(ws + WS_HF + (size_t)T * D * 2), (const float*)(ws + WS_LSE), pp->in[7] + (size_t)l * 3 * QD, pp->in[8] + (size_t)l * QD, pp->in[9] + (size_t)l * QD,
                                (bf16_t*)(ws + WS_HF), 0, ROW0(c), RSTRIDE(c), NROWS(), c.lane); }
                GRID_BAR();
                { const Params* pp = get_params(); unsigned char* ws = pp->ws; const int G = gridDim.x, bid = vbid;
                  pg8::Gemm g{(const bf16_t*)(ws + WS_HF), (const bf16_t*)(ws + WS_W + (size_t)l * SZ_LAYER + OFF_OUT), T, D, D}; pg8::StaticOrder S; S.init(T, D, G, bid); pg8::EpiBf16 E{(bf16_t*)(ws + WS_HF + (size_t)T * D * 2), D};
                  pg8::gemm_phase<pg8::EpiBf16, pg8::StaticOrder, true, true>(lds, g, S, E, make_tid(wave_s)); }
                GRID_BAR();
                { const Params* pp = get_params(); unsigned char* ws = pp->ws; const Ctx c = make_ctx(wave_s);
                  normres_phase((const bf16_t*)(ws + WS_HF + (size_t)T * D * 2), nullptr, pp->in[5] + (size_t)l * D, (bf16_t*)(ws + WS_XN), (bf16_t*)(ws + WS_LO), (float*)(ws + WS_RS), nullptr, pp->in[11] + (size_t)l * D, 1.0f, pp->in[12] + (size_t)l * D, NR_ARGS(c)); ++nri; }
                GRID_BAR();
            }
            { const Params* pp = get_params(); unsigned char* ws = pp->ws; const int G = gridDim.x, bid = vbid;
              pg8::Gemm g{(const bf16_t*)(ws + WS_XN), (const bf16_t*)(ws + WS_W + (size_t)l * SZ_LAYER + (f ? OFF_GU2 : OFF_GU1)), T, NGU, D}; pg8::StaticOrder S; S.init(T, NGU, G, bid); pg8::EpiSwiGLU E{(bf16_t*)(ws + WS_BIG), FF};
              pg8::gemm_phase<pg8::EpiSwiGLU, pg8::StaticOrder, true, true>(lds, g, S, E, make_tid(wave_s)); }
            GRID_BAR();
            { const Params* pp = get_params(); unsigned char* ws = pp->ws; const int G = gridDim.x, bid = vbid;
              pg8::Gemm g{(const bf16_t*)(ws + WS_BIG), (const bf16_t*)(ws + WS_W + (size_t)l * SZ_LAYER + (f ? OFF_D2 : OFF_D1)), T, D, FF}; pg8::StaticOrder S; S.init(T, D, G, bid); pg8::EpiBf16 E{(bf16_t*)(ws + WS_HF), D};
              pg8::gemm_phase<pg8::EpiBf16, pg8::StaticOrder, true, true>(lds, g, S, E, make_tid(wave_s)); }
            GRID_BAR();
            { const Params* pp = get_params(); unsigned char* ws = pp->ws; const Ctx c = make_ctx(wave_s);
              const float* gpost = (f ? pp->in[15] : pp->in[4]) + (size_t)l * D;
              const float* gpre = f ? (l + 1 < DEPTH ? pp->in[1] + (size_t)(l + 1) * D : nullptr) : pp->in[5] + (size_t)l * D;
              const float* gprev = (f ? pp->in[12] : pp->in[1]) + (size_t)l * D;
              const float* xsrc = (l == 0 && f == 0) ? pp->in[0] : nullptr;
              float* xdst = (l == DEPTH - 1 && f == 1) ? pp->out : nullptr;
              normres_phase((const bf16_t*)(ws + WS_HF), xsrc, gprev, (bf16_t*)(ws + WS_XN), (bf16_t*)(ws + WS_LO), (float*)(ws + WS_RS), xdst, gpost, 0.5f, gpre, NR_ARGS(c)); ++nri; }
            if (!(l == DEPTH - 1 && f == 1)) GRID_BAR();
        }
    }
}

extern "C" void kernel_launch(void* const* d_in, const int* in_sizes, int n_in, void* d_out, int out_size, void* d_ws, size_t ws_size, hipStream_t stream) {
    static int grid_blocks = 0;
    if (grid_blocks == 0) {
        if (n_in != 16 || out_size != T * D || ws_size < WS_END) { fprintf(stderr, "kernel_launch: unexpected shapes (n_in %d out %d ws %zu need %zu)\n", n_in, out_size, ws_size, (size_t)WS_END); grid_blocks = -1; return; }
        int dev = 0, cus = 0, per_cu = 0;
        hipGetDevice(&dev);
        hipDeviceGetAttribute(&cus, hipDeviceAttributeMultiprocessorCount, dev);
        if (hipFuncSetAttribute((const void*)fwd_megakernel, hipFuncAttributeMaxDynamicSharedMemorySize, LDS_BYTES) != hipSuccess) { fprintf(stderr, "kernel_launch: hipFuncSetAttribute failed\n"); }
        if (hipOccupancyMaxActiveBlocksPerMultiprocessor(&per_cu, (const void*)fwd_megakernel, NTHREADS, LDS_BYTES) != hipSuccess || per_cu < 1) { fprintf(stderr, "kernel_launch: occupancy query gave %d\n", per_cu); per_cu = 1; }
        (void)hipGetLastError();
        grid_blocks = cus * 1;
        if (grid_blocks <= 0) grid_blocks = 256;
    }
    if (grid_blocks < 0) return;
    Params p{};
    for (int i = 0; i < 16; ++i) p.in[i] = (const float*)d_in[i];
    p.out = (float*)d_out; p.ws = (unsigned char*)d_ws;
    if (hipMemsetAsync((unsigned char*)d_ws + WS_CTL, 0, 32768, stream) != hipSuccess) fprintf(stderr, "kernel_launch: memset of barrier words failed\n");
    void* args[] = {&p};
    hipError_t e = hipLaunchCooperativeKernel((const void*)fwd_megakernel, dim3(grid_blocks), dim3(NTHREADS), args, LDS_BYTES, stream);
    if (e != hipSuccess) fprintf(stderr, "cooperative launch failed: %s (grid %d)\n", hipGetErrorString(e), grid_blocks);
}
```

```cpp
#include <hip/hip_runtime.h>
#include <hip/hip_cooperative_groups.h>
#include <cstdio>
#include <cstdint>
namespace pg8 {
#define PG8_LAS __attribute__((address_space(3)))
typedef unsigned short bf16_t;
typedef short bf16x8 __attribute__((ext_vector_type(8)));
typedef float f32x4 __attribute__((ext_vector_type(4)));
typedef unsigned u32x4 __attribute__((ext_vector_type(4)));
constexpr int BM = 256, BK = 64, HALF = 128, HTB = HALF * BK * 2  , STAGE_BYTES = 8 * HTB, NXCD = 8, WGM = 8;

__host__ __device__ __forceinline__ int lds_byte(int r, int c) { const int st = (r >> 4) * 2 + (c >> 5), rr = r & 15, cc = c & 31, ob = rr * 64 + cc * 2; return st * 1024 + (ob ^ (((ob >> 9) & 1) << 5)); }
__host__ __device__ __forceinline__ void stage_rc(int b, int& R, int& C) { const int st = b / 1024, sb = b % 1024, swz = sb ^ (((sb >> 9) & 1) << 5); R = (st >> 1) * 16 + swz / 64; C = (st & 1) * 32 + (swz % 64) / 2; }
__host__ __device__ __forceinline__ int perm32(int rho) { const int n = rho >> 4, i = rho & 15; return 8 * (i >> 2) + 4 * n + (i & 3); }

struct Unit { int pm, pn; };
struct Gemm { const bf16_t* A; const bf16_t* Bt; int M, N, K; };

struct StaticOrder {
    int nM, nN, nwg, G, c;
    __host__ __device__ void init(int M, int N, int G_, int c_) { nM = M / BM; nN = N / BM; nwg = nM * nN; G = G_; c = c_; }
    __host__ __device__ bool next(int i, Unit& u) const {
        const long L = (long)i * G + c; if (L >= nwg) return false;
        int wgid = (int)L; { const int q = nwg / NXCD, r = nwg % NXCD, xcd = wgid % NXCD, off = wgid / NXCD; wgid = (xcd < r ? xcd * (q + 1) : r * (q + 1) + (xcd - r) * q) + off; }
        const int nig = WGM * nN, gid = wgid / nig, fm = gid * WGM, gsz = (nM - fm) < WGM ? (nM - fm) : WGM;
        u.pm = fm + ((wgid % nig) % gsz); u.pn = (wgid % nig) / gsz; return true;
    }
    __device__ __forceinline__ void a_ready(const Unit&) const {}
    __device__ __forceinline__ void done(const Unit&) const {}
};
__device__ __forceinline__ unsigned cvt_pk_bf16(float lo, float hi) { unsigned r; asm volatile("v_cvt_pk_bf16_f32 %0, %1, %2" : "=v"(r) : "v"(lo), "v"(hi)); return r; }
struct EpiF32 {
    static constexpr bool PERM = false, AFTER_DRAIN = false;
    float* C; int ldc;
    __device__ __forceinline__ void operator()(const f32x4 (&acc)[2][2][4][2], const Unit& u, int wr, int wc, int fr, int fq) const {
        const int row0 = u.pm * BM + wr * 64 + fr, col0 = u.pn * BM + wc * 32 + 4 * fq;
#pragma unroll
        for (int ai = 0; ai < 2; ++ai)
#pragma unroll
            for (int m = 0; m < 4; ++m) { float* rowp = C + (size_t)(row0 + ai * HALF + m * 16) * ldc + col0;
#pragma unroll
                for (int bj = 0; bj < 2; ++bj)
#pragma unroll
                    for (int n = 0; n < 2; ++n) *(f32x4*)(rowp + bj * HALF + n * 16) = acc[ai][bj][m][n]; }
    }
};
struct EpiBf16 {
    static constexpr bool PERM = true, AFTER_DRAIN = false;
    bf16_t* O; int ldc;
    __device__ __forceinline__ void operator()(const f32x4 (&acc)[2][2][4][2], const Unit& u, int wr, int wc, int fr, int fq) const {
        const int row0 = u.pm * BM + wr * 64 + fr, col0 = u.pn * BM + wc * 32 + 8 * fq;
#pragma unroll
        for (int ai = 0; ai < 2; ++ai)
#pragma unroll
            for (int m = 0; m < 4; ++m) { bf16_t* rowp = O + (size_t)(row0 + ai * HALF + m * 16) * ldc + col0;
#pragma unroll
                for (int bj = 0; bj < 2; ++bj) { const f32x4 v0 = acc[ai][bj][m][0], v1 = acc[ai][bj][m][1];
                    u32x4 w; w.x = cvt_pk_bf16(v0[0], v0[1]); w.y = cvt_pk_bf16(v0[2], v0[3]); w.z = cvt_pk_bf16(v1[0], v1[1]); w.w = cvt_pk_bf16(v1[2], v1[3]);
                    *(u32x4*)(rowp + bj * HALF) = w; } }
    }
};
__device__ __forceinline__ float silu_mul(float g, float u) { return g * u * __builtin_amdgcn_rcpf(1.0f + __builtin_amdgcn_exp2f(g * -1.4426950408889634f)); }
struct EpiSwiGLU {
    static constexpr bool PERM = true, AFTER_DRAIN = false;
    bf16_t* O; int ldc;
    __device__ __forceinline__ void operator()(const f32x4 (&acc)[2][2][4][2], const Unit& u, int wr, int wc, int fr, int fq) const {
        const int row0 = u.pm * BM + wr * 64 + fr, col0 = u.pn * HALF + wc * 32 + 8 * fq;
#pragma unroll
        for (int ai = 0; ai < 2; ++ai)
#pragma unroll
            for (int m = 0; m < 4; ++m) { bf16_t* rowp = O + (size_t)(row0 + ai * HALF + m * 16) * ldc + col0;
                const f32x4 g0 = acc[ai][0][m][0], g1 = acc[ai][0][m][1], u0 = acc[ai][1][m][0], u1 = acc[ai][1][m][1];
                u32x4 w; w.x = cvt_pk_bf16(silu_mul(g0[0], u0[0]), silu_mul(g0[1], u0[1])); w.y = cvt_pk_bf16(silu_mul(g0[2], u0[2]), silu_mul(g0[3], u0[3]));
                w.z = cvt_pk_bf16(silu_mul(g1[0], u1[0]), silu_mul(g1[1], u1[1])); w.w = cvt_pk_bf16(silu_mul(g1[2], u1[2]), silu_mul(g1[3], u1[3]));
                *(u32x4*)rowp = w; }
    }
};

template <class Epi, class Sched, bool ALIGN_EPI = false, bool SP2 = false>
__device__ __forceinline__ void gemm_phase(PG8_LAS unsigned char* lds, const Gemm g, const Sched& S, const Epi& E, int tid_in) {
    int tid_l = tid_in; asm volatile("" : "+v"(tid_l));
    const int tid = tid_l, wid = __builtin_amdgcn_readfirstlane(tid >> 6), lane = tid & 63, wr = wid >> 2, wc = wid & 3, fr = lane & 15, fq = lane >> 4;
    const int K = g.K, nt = K / BK;
    unsigned voffA[2], voffB[2];
#pragma unroll
    for (int i = 0; i < 2; ++i) { int R, C; stage_rc(tid * 16 + i * 8192, R, C); const int Rb = Epi::PERM ? ((R & ~31) + perm32(R & 31)) : R;
        voffA[i] = (unsigned)(R * K + C) * 2u; voffB[i] = (unsigned)(Rb * K + C) * 2u; }
    const size_t kstep = (size_t)(BK * 2);
    const size_t hstep = (size_t)HALF * K * 2;
    const size_t tstep = 2 * hstep;
    const unsigned ldsw = (unsigned)wid * 1024u;
    const int aoff = lds_byte(wr * 64 + fr, fq * 8), boff = lds_byte(wc * 32 + fr, fq * 8);
#define PG8_SA(b, h) (((b) * 2 + (h)) * HTB)
#define PG8_SB(b, h) ((4 + (b) * 2 + (h)) * HTB)
#define PG8_STAGE(bufoff, gbase, voff) do { _Pragma("unroll") for (int _i = 0; _i < 2; ++_i) \
        __builtin_amdgcn_global_load_lds((const unsigned*)((const char*)(gbase) + (voff)[_i]), (PG8_LAS unsigned*)(lds + (bufoff) + ldsw + _i * 8192), 16, 0, 0); } while (0)
#define PG8_LDA(dst, b, h) do { _Pragma("unroll") for (int m = 0; m < 4; ++m) _Pragma("unroll") for (int k = 0; k < 2; ++k) dst[m][k] = *(const PG8_LAS bf16x8*)(lds + PG8_SA(b, h) + aoff + m * 2048 + k * 1024); } while (0)
#define PG8_LDB(dst, b, h) do { _Pragma("unroll") for (int n = 0; n < 2; ++n) _Pragma("unroll") for (int k = 0; k < 2; ++k) dst[n][k] = *(const PG8_LAS bf16x8*)(lds + PG8_SB(b, h) + boff + n * 2048 + k * 1024); } while (0)
#define PG8_MMA(ai, bj, At, Bt) do { __builtin_amdgcn_s_setprio(1); _Pragma("unroll") for (int m = 0; m < 4; ++m) _Pragma("unroll") for (int n = 0; n < 2; ++n) _Pragma("unroll") for (int k = 0; k < 2; ++k) \
        acc[ai][bj][m][n] = __builtin_amdgcn_mfma_f32_16x16x32_bf16(Bt[n][k], At[m][k], acc[ai][bj][m][n], 0, 0, 0); __builtin_amdgcn_s_setprio(0); } while (0)
#define PG8_WAIT_V(n) asm volatile("s_waitcnt vmcnt(" #n ")" ::: "memory")
#define PG8_WAIT_L(n) asm volatile("s_waitcnt lgkmcnt(" #n ")" ::: "memory")
#define PG8_BAR __builtin_amdgcn_s_barrier()
#define PG8_SCHED __builtin_amdgcn_sched_barrier(0)
    Unit cur, nxt; int ui = 0;
    if (!S.next(0, cur)) return;
    f32x4 acc[2][2][4][2];
#pragma unroll
    for (int a = 0; a < 2; ++a)
#pragma unroll
        for (int b = 0; b < 2; ++b)
#pragma unroll
            for (int m = 0; m < 4; ++m)
#pragma unroll
                for (int n = 0; n < 2; ++n) acc[a][b][m][n] = (f32x4){0.f, 0.f, 0.f, 0.f};
    bf16x8 At[4][2], B0[2][2], B1[2][2];
    const char* cA = (const char*)g.A + (size_t)cur.pm * tstep; const char* cB = (const char*)g.Bt + (size_t)cur.pn * tstep;
    S.a_ready(cur);
    if constexpr (SP2) {
        PG8_STAGE(PG8_SB(0, 0), cB, voffB); PG8_STAGE(PG8_SB(0, 1), cB + hstep, voffB); PG8_STAGE(PG8_SA(0, 0), cA, voffA); PG8_STAGE(PG8_SA(0, 1), cA + hstep, voffA);
        if (wr == 1) PG8_BAR;
        PG8_WAIT_V(2); PG8_BAR;
        PG8_STAGE(PG8_SB(1, 0), cB + kstep, voffB); PG8_STAGE(PG8_SA(1, 0), cA + kstep, voffA); PG8_STAGE(PG8_SB(1, 1), cB + hstep + kstep, voffB);
        PG8_WAIT_V(6); PG8_BAR;
    } else {
        PG8_STAGE(PG8_SB(0, 0), cB, voffB); PG8_STAGE(PG8_SA(0, 0), cA, voffA); PG8_STAGE(PG8_SB(0, 1), cB + hstep, voffB); PG8_STAGE(PG8_SA(0, 1), cA + hstep, voffA);
        if (wr == 1) PG8_BAR;
        PG8_WAIT_V(4); PG8_BAR;
        PG8_STAGE(PG8_SB(1, 0), cB + kstep, voffB); PG8_STAGE(PG8_SA(1, 0), cA + kstep, voffA); PG8_STAGE(PG8_SB(1, 1), cB + hstep + kstep, voffB);
        PG8_WAIT_V(6); PG8_BAR;
    }
    for (;;) {
        const bool has_next = S.next(ui + 1, nxt);
        const char* nA = has_next ? (const char*)g.A + (size_t)nxt.pm * tstep : cA; const char* nB = has_next ? (const char*)g.Bt + (size_t)nxt.pn * tstep : cB;
        for (int t = 0; t < nt; t += 2) {
            const bool last = (t == nt - 2);
            const char* a1 = cA + (size_t)(t + 1) * kstep;
            const char* a2 = last ? nA : cA + (size_t)(t + 2) * kstep; const char* b2 = last ? nB : cB + (size_t)(t + 2) * kstep;
            const char* a3 = a2 + kstep; const char* b3 = b2 + kstep;
            if (last && has_next) S.a_ready(nxt);
            if constexpr (SP2) {
            PG8_LDB(B0, 0, 0); PG8_LDB(B1, 0, 1); PG8_SCHED; PG8_LDA(At, 0, 0); PG8_STAGE(PG8_SA(1, 1), a1 + hstep, voffA);
            PG8_WAIT_V(8); PG8_WAIT_L(0); PG8_BAR; PG8_MMA(0, 0, At, B0); PG8_MMA(0, 1, At, B1); PG8_BAR; PG8_SCHED;
            PG8_LDA(At, 0, 1); PG8_STAGE(PG8_SB(0, 0), b2, voffB); PG8_STAGE(PG8_SB(0, 1), b2 + hstep, voffB); PG8_STAGE(PG8_SA(0, 0), a2, voffA);
            PG8_WAIT_V(8); PG8_WAIT_L(0); PG8_BAR; PG8_MMA(1, 0, At, B0); PG8_MMA(1, 1, At, B1); PG8_BAR; PG8_SCHED;
            PG8_LDB(B0, 1, 0); PG8_LDB(B1, 1, 1); PG8_SCHED; PG8_LDA(At, 1, 0); PG8_STAGE(PG8_SA(0, 1), a2 + hstep, voffA);
            PG8_WAIT_V(8); PG8_WAIT_L(0); PG8_BAR; PG8_MMA(0, 0, At, B0); PG8_MMA(0, 1, At, B1); PG8_BAR; PG8_SCHED;
            PG8_LDA(At, 1, 1); PG8_STAGE(PG8_SB(1, 0), b3, voffB); PG8_STAGE(PG8_SB(1, 1), b3 + hstep, voffB); PG8_STAGE(PG8_SA(1, 0), a3, voffA);
            PG8_WAIT_V(8); PG8_WAIT_L(0); PG8_BAR; PG8_MMA(1, 0, At, B0); PG8_MMA(1, 1, At, B1); PG8_BAR; PG8_SCHED;
            } else {
            PG8_LDB(B0, 0, 0); PG8_SCHED; PG8_LDA(At, 0, 0); PG8_STAGE(PG8_SA(1, 1), a1 + hstep, voffA);
            PG8_WAIT_L(8); PG8_BAR; PG8_WAIT_L(0); PG8_MMA(0, 0, At, B0); PG8_BAR; PG8_SCHED;
            PG8_LDB(B1, 0, 1); PG8_STAGE(PG8_SB(0, 0), b2, voffB);
            PG8_BAR; PG8_WAIT_L(0); PG8_MMA(0, 1, At, B1); PG8_BAR;
            PG8_LDA(At, 0, 1); PG8_STAGE(PG8_SA(0, 0), a2, voffA);
            PG8_BAR; PG8_WAIT_L(0); PG8_MMA(1, 0, At, B0); PG8_BAR; PG8_SCHED;
            PG8_STAGE(PG8_SB(0, 1), b2 + hstep, voffB);
            PG8_WAIT_V(6); PG8_BAR; PG8_MMA(1, 1, At, B1); PG8_BAR;
            PG8_LDB(B0, 1, 0); PG8_SCHED; PG8_LDA(At, 1, 0); PG8_STAGE(PG8_SA(0, 1), a2 + hstep, voffA);
            PG8_WAIT_L(8); PG8_BAR; PG8_WAIT_L(0); PG8_MMA(0, 0, At, B0); PG8_BAR; PG8_SCHED;
            PG8_LDB(B1, 1, 1); PG8_STAGE(PG8_SB(1, 0), b3, voffB);
            PG8_BAR; PG8_WAIT_L(0); PG8_MMA(0, 1, At, B1); PG8_BAR;
            PG8_LDA(At, 1, 1); PG8_STAGE(PG8_SA(1, 0), a3, voffA);
            PG8_BAR; PG8_WAIT_L(0); PG8_MMA(1, 0, At, B0); PG8_BAR; PG8_SCHED;
            PG8_STAGE(PG8_SB(1, 1), b3 + hstep, voffB);
            PG8_WAIT_V(6); PG8_BAR; PG8_MMA(1, 1, At, B1); PG8_BAR;
            }
        }
        if constexpr (ALIGN_EPI) { if (wr == 0) PG8_BAR; }
        if constexpr (!Epi::AFTER_DRAIN) { E(acc, cur, wr, wc, fr, fq); S.done(cur); }
        if (!has_next) break;
#pragma unroll
        for (int a = 0; a < 2; ++a)
#pragma unroll
            for (int b = 0; b < 2; ++b)
#pragma unroll
                for (int m = 0; m < 4; ++m)
#pragma unroll
                    for (int n = 0; n < 2; ++n) acc[a][b][m][n] = (f32x4){0.f, 0.f, 0.f, 0.f};
        cur = nxt; cA = nA; cB = nB; ++ui;
        if constexpr (ALIGN_EPI) { if (wr == 1) PG8_BAR; }
    }
    PG8_WAIT_V(0);
    if constexpr (!ALIGN_EPI) { if (wr == 0) PG8_BAR; }
    PG8_BAR;
    if constexpr (Epi::AFTER_DRAIN) { E.fused(acc, cur, wr, wc, fr, fq, lds, wid, lane); S.done(cur); }
#undef PG8_SA
#undef PG8_SB
#undef PG8_STAGE
#undef PG8_LDA
#undef PG8_LDB
#undef PG8_MMA
#undef PG8_WAIT_V
#undef PG8_WAIT_L
#undef PG8_BAR
#undef PG8_SCHED
}
}
namespace cg = cooperative_groups;
#define LAS __attribute__((address_space(3)))
typedef unsigned short bf16_t;
typedef short bf16x8 __attribute__((ext_vector_type(8)));
typedef float f32x4 __attribute__((ext_vector_type(4)));
typedef unsigned u32x4 __attribute__((ext_vector_type(4)));
typedef unsigned u32x2 __attribute__((ext_vector_type(2)));
typedef __bf16 bf16x2_n __attribute__((ext_vector_type(2)));
typedef float f32x2 __attribute__((ext_vector_type(2)));

constexpr int T = 16384, SEQ = 2048, D = 2048, FF = 5632, NGU = 2 * FF, NIN = 4608, QD = 1024, DEPTH = 2;
constexpr int ZP = FF;
constexpr float EPS = 1e-6f;
constexpr int NTHREADS = 512, NWAVES = 8;
constexpr int LDS_BYTES = 144 * 1024;
constexpr size_t SZ_GU = (size_t)NGU * D * 2, SZ_DN = (size_t)D * FF * 2, SZ_IN = (size_t)NIN * D * 2, SZ_OUT = (size_t)D * D * 2;
constexpr size_t OFF_GU1 = 0, OFF_D1 = OFF_GU1 + SZ_GU, OFF_IN = OFF_D1 + SZ_DN, OFF_OUT = OFF_IN + SZ_IN, OFF_GU2 = OFF_OUT + SZ_OUT, OFF_D2 = OFF_GU2 + SZ_GU, SZ_LAYER = OFF_D2 + SZ_DN;
constexpr size_t WS_W = 0, WS_XN = WS_W + DEPTH * SZ_LAYER, WS_BIG = WS_XN + (size_t)T * D * 2, WS_HF = WS_BIG + (size_t)T * FF * 2, WS_CTL = WS_HF + (size_t)T * D * 4, WS_LSE = WS_CTL + 32768, WS_RS = WS_LSE + (size_t)3 * T * 8 * 4, WS_LO = WS_RS + (size_t)T * 4, WS_END = WS_LO + (size_t)T * D * 2;
constexpr size_t OB_STRIDE = (size_t)T * QD;
constexpr size_t LSE_OFF = 3 * OB_STRIDE * 2;

struct Params { const float* in[16]; float* out; unsigned char* ws; };

__device__ __forceinline__ float wave_sum(float v) {
#pragma unroll
    for (int o = 1; o < 64; o <<= 1) v += __shfl_xor(v, o);
    return v;
}
__device__ __forceinline__ unsigned pk2(float lo, float hi) {
    const bf16x2_n r = __builtin_convertvector((f32x2){lo, hi}, bf16x2_n);
    return __builtin_bit_cast(unsigned, r);
}
__device__ __forceinline__ float bflo(unsigned w) { return __uint_as_float(w << 16); }
__device__ __forceinline__ float bfhi(unsigned w) { return __uint_as_float(w & 0xffff0000u); }
__device__ __forceinline__ float dot4(f32x4 a) { return (a.x * a.x + a.y * a.y) + (a.z * a.z + a.w * a.w); }

__device__ __forceinline__ void transpose_item(const float* W, int K, int N, bf16_t* WT, bool gu, LAS unsigned* scr, int item, int lane) {
    const int nblk = N / 64, kb = item / nblk, nb = item - kb * nblk, k0 = 64 * kb, n0 = 64 * nb;
    const int n4 = lane & 15, kq = lane >> 4;
    const float* src = W + (size_t)(k0 + 2 * kq) * N + n0 + 4 * n4;
    f32x4 L0[8], L1[8];
#pragma unroll
    for (int i = 0; i < 8; ++i) { L0[i] = *(const f32x4*)(src + (size_t)(8 * i) * N); L1[i] = *(const f32x4*)(src + (size_t)(8 * i + 1) * N); }
#pragma unroll
    for (int i = 0; i < 8; ++i) { const int kp = 4 * i + kq;
#pragma unroll
        for (int j = 0; j < 4; ++j) scr[(4 * n4 + j) * 33 + kp] = pk2(L0[i][j], L1[i][j]); }
    asm volatile("s_waitcnt lgkmcnt(0)" ::: "memory");
    int row0 = n0;
    if (gu) { const int up = n0 >= FF, nn = up ? n0 - FF : n0; row0 = 256 * (nn >> 7) + (up ? 128 : 0) + (nn & 127); }
    const int c = lane & 7;
#pragma unroll
    for (int j = 0; j < 8; ++j) { const int n = (lane >> 3) + 8 * j; const LAS unsigned* s = scr + n * 33 + 4 * c;
        u32x4 o; o.x = s[0]; o.y = s[1]; o.z = s[2]; o.w = s[3];
        *(u32x4*)(WT + (size_t)(row0 + n) * K + k0 + 8 * c) = o; }
    asm volatile("s_waitcnt lgkmcnt(0)" ::: "memory");
}
constexpr int IT_GU = (D / 64) * (NGU / 64), IT_DN = (FF / 64) * (D / 64), IT_IN = (D / 64) * (NIN / 64), IT_OUT = (D / 64) * (D / 64);
constexpr int IT_LAYER = 2 * IT_GU + 2 * IT_DN + IT_IN + IT_OUT;

__device__ __forceinline__ void prologue_phase(const Params& p, LAS unsigned char* lds, int gw, int ngw, int wave, int lane) {
    LAS unsigned* scr = (LAS unsigned*)(lds + wave * 16384);
    unsigned char* wsw = p.ws + WS_W;
    for (int it = gw; it < DEPTH * IT_LAYER; it += ngw) {
        const int l = it / IT_LAYER; int r = it - l * IT_LAYER;
        unsigned char* wl = wsw + (size_t)l * SZ_LAYER;
        if (r < IT_GU) { transpose_item(p.in[2] + (size_t)l * D * NGU, D, NGU, (bf16_t*)(wl + OFF_GU1), true, scr, r, lane); continue; } r -= IT_GU;
        if (r < IT_DN) { transpose_item(p.in[3] + (size_t)l * FF * D, FF, D, (bf16_t*)(wl + OFF_D1), false, scr, r, lane); continue; } r -= IT_DN;
        if (r < IT_IN) { transpose_item(p.in[6] + (size_t)l * D * NIN, D, NIN, (bf16_t*)(wl + OFF_IN), false, scr, r, lane); continue; } r -= IT_IN;
        if (r < IT_OUT) { transpose_item(p.in[10] + (size_t)l * D * D, D, D, (bf16_t*)(wl + OFF_OUT), false, scr, r, lane); continue; } r -= IT_OUT;
        if (r < IT_GU) { transpose_item(p.in[13] + (size_t)l * D * NGU, D, NGU, (bf16_t*)(wl + OFF_GU2), true, scr, r, lane); continue; } r -= IT_GU;
        transpose_item(p.in[14] + (size_t)l * FF * D, FF, D, (bf16_t*)(wl + OFF_D2), false, scr, r, lane);
    }
    const float* x = p.in[0]; const f32x4* g4 = (const f32x4*)p.in[1]; bf16_t* XN = (bf16_t*)(p.ws + WS_XN);
    for (int row = gw; row < T; row += ngw) {
        const f32x4* xr = (const f32x4*)(x + (size_t)row * D) + lane; f32x4 v[8]; float ss = 0.f;
#pragma unroll
        for (int j = 0; j < 8; ++j) { v[j] = xr[64 * j]; ss += dot4(v[j]); }
        const float rs = rsqrtf(wave_sum(ss) * (1.f / D) + EPS);
        u32x2* o = (u32x2*)(XN + (size_t)row * D) + lane;
#pragma unroll
        for (int j = 0; j < 8; ++j) { const f32x4 y = v[j] * rs * g4[lane + 64 * j]; o[64 * j] = (u32x2){pk2(y.x, y.y), pk2(y.z, y.w)}; }
    }
}

__device__ __forceinline__ f32x4 bf4lo(u32x4 w) { return (f32x4){bflo(w.x), bfhi(w.x), bflo(w.y), bfhi(w.y)}; }
__device__ __forceinline__ f32x4 bf4hi(u32x4 w) { return (f32x4){bflo(w.z), bfhi(w.z), bflo(w.w), bfhi(w.w)}; }
__device__ __forceinline__ f32x4 rcp4(f32x4 g) { return (f32x4){__builtin_amdgcn_rcpf(g.x), __builtin_amdgcn_rcpf(g.y), __builtin_amdgcn_rcpf(g.z), __builtin_amdgcn_rcpf(g.w)}; }
__device__ __forceinline__ void normres_phase(const bf16_t* hf, const float* xsrc, const float* gprev, bf16_t* HI, bf16_t* LO, float* RS, float* xdst, const float* gpost, float w, const float* gpre,
                                              int row0, int rstride, int nrows, unsigned* ctr, int poolbase, int npool, int lane) {
    const int nstat = (nrows + 1) >> 1; unsigned vnext = 0u;
    for (int trip = 0; ; ++trip) {
        int row, rowb; bool two;
        if (trip < nstat) {
            row = row0 + 2 * trip * rstride; if (row >= T) break;
            two = (2 * trip + 1 < nrows) && (row + rstride < T); rowb = two ? row + rstride : row;
            if (ctr != nullptr && trip == nstat - 1 && lane == 0) vnext = __hip_atomic_fetch_add(ctr, 1u, __ATOMIC_RELAXED, __HIP_MEMORY_SCOPE_AGENT);
        } else {
            if (ctr == nullptr) break;
            const unsigned pcur = (unsigned)__builtin_amdgcn_readfirstlane((int)vnext); if (pcur >= (unsigned)npool) break;
            row = poolbase + 2 * (int)pcur; rowb = row + 1; two = true;
            if (lane == 0) vnext = __hip_atomic_fetch_add(ctr, 1u, __ATOMIC_RELAXED, __HIP_MEMORY_SCOPE_AGENT);
        }
        u32x4 hw[2][4]; f32x4 xv[2][8];
        if (xsrc) {
#pragma unroll
            for (int q = 0; q < 2; ++q) { const int rr = q ? rowb : row;
                const u32x4* hr = (const u32x4*)(hf + (size_t)rr * D) + lane; const f32x4* xr = (const f32x4*)(xsrc + (size_t)rr * D) + 2 * lane;
#pragma unroll
                for (int c = 0; c < 4; ++c) { hw[q][c] = hr[64 * c]; xv[q][2 * c] = xr[128 * c]; xv[q][2 * c + 1] = xr[128 * c + 1]; } }
        } else {
            u32x4 hiw[2][4]; float rsp[2];
#pragma unroll
            for (int q = 0; q < 2; ++q) { const int rr = q ? rowb : row;
                const u32x4* hr = (const u32x4*)(hf + (size_t)rr * D) + lane; const u32x4* ar = (const u32x4*)(HI + (size_t)rr * D) + lane;
                rsp[q] = RS[rr];
#pragma unroll
                for (int c = 0; c < 4; ++c) { hw[q][c] = hr[64 * c]; hiw[q][c] = ar[64 * c]; } }
            const f32x4* gv4 = (const f32x4*)gprev + 2 * lane;
#pragma unroll
            for (int c = 0; c < 4; ++c) { const f32x4 ig0 = rcp4(gv4[128 * c]), ig1 = rcp4(gv4[128 * c + 1]);
#pragma unroll
                for (int q = 0; q < 2; ++q) { const float inv = __builtin_amdgcn_rcpf(rsp[q]);
                    xv[q][2 * c] = bf4lo(hiw[q][c]) * ig0 * inv; xv[q][2 * c + 1] = bf4hi(hiw[q][c]) * ig1 * inv; } }
        }
#pragma unroll
        for (int q = 0; q < 2; ++q) { if (q == 1 && !two) break; const int rr = q ? rowb : row;
            float ss = 0.f;
#pragma unroll
            for (int c = 0; c < 4; ++c) ss += dot4(bf4lo(hw[q][c])) + dot4(bf4hi(hw[q][c]));
            const float rs = rsqrtf(wave_sum(ss) * (1.f / D) + EPS) * w; float ss2 = 0.f;
            const f32x4* gp4 = (const f32x4*)gpost + 2 * lane;
#pragma unroll
            for (int c = 0; c < 4; ++c) { xv[q][2 * c] = xv[q][2 * c] + bf4lo(hw[q][c]) * rs * gp4[128 * c]; xv[q][2 * c + 1] = xv[q][2 * c + 1] + bf4hi(hw[q][c]) * rs * gp4[128 * c + 1];
                ss2 += dot4(xv[q][2 * c]) + dot4(xv[q][2 * c + 1]); }
            if (xdst) {
                f32x4* xo = (f32x4*)(xdst + (size_t)rr * D) + 2 * lane;
#pragma unroll
                for (int c = 0; c < 4; ++c) { xo[128 * c] = xv[q][2 * c]; xo[128 * c + 1] = xv[q][2 * c + 1]; }
            } else {
                const float rs2 = rsqrtf(wave_sum(ss2) * (1.f / D) + EPS);
                const f32x4* gn4 = (const f32x4*)gpre + 2 * lane; u32x4* oh = (u32x4*)(HI + (size_t)rr * D) + lane;
#pragma unroll
                for (int c = 0; c < 4; ++c) { const f32x4 y0 = xv[q][2 * c] * rs2 * gn4[128 * c], y1 = xv[q][2 * c + 1] * rs2 * gn4[128 * c + 1];
                    oh[64 * c] = (u32x4){pk2(y0.x, y0.y), pk2(y0.z, y0.w), pk2(y1.x, y1.y), pk2(y1.z, y1.w)}; }
                if (lane == 0) RS[rr] = rs2;
            }
        }
    }
}

constexpr int KS_STRIDE = 272, VT_STRIDE = 528, VT_OFF = 256 * KS_STRIDE;
static_assert(VT_OFF + 128 * VT_STRIDE <= LDS_BYTES, "attention LDS");
#define MFMA16(a, b, c) __builtin_amdgcn_mfma_f32_16x16x32_bf16((a), (b), (c), 0, 0, 0)
__device__ __forceinline__ void attn_phase(LAS unsigned char* lds, bf16_t* Z, bf16_t* OB12, float* LSE, int it0, int itstride, int nit, int tid) {
    const int wid = __builtin_amdgcn_readfirstlane(tid >> 6), lane = tid & 63, l15 = lane & 15, quad = lane >> 4;
    for (int ki = 0, it = it0; ki < nit && it < 768; ++ki, it += itstride) {
        const int sub = it & 15, br = (it >> 4) % 3, bg = it / 48, g = bg & 1, b = bg >> 1;
        int d, n, e; if (br == 0) { d = 1; n = sub; e = 0; } else if (br == 1) { d = 4; n = sub >> 2; e = sub & 3; } else { d = 16; n = 0; e = sub; }
        __syncthreads();
        {
            const int kp = tid >> 2, qtr = tid & 3, kj0 = 2 * kp;
            const bool valid = (n > 0) || (kj0 >= 128);
            u32x4 k0[4], k1[4], v0[4], v1[4];
            if (valid) {
                const int p0 = ((n - 1) * 128 + kj0) * d + e;
                const bf16_t* r0 = Z + (size_t)(b * SEQ + p0) * ZP + g * 128 + qtr * 32; const bf16_t* r1 = r0 + (size_t)d * ZP;
#pragma unroll
                for (int i = 0; i < 4; ++i) { k0[i] = *(const u32x4*)(r0 + 1024 + 8 * i); k1[i] = *(const u32x4*)(r1 + 1024 + 8 * i); v0[i] = *(const u32x4*)(r0 + 1280 + 8 * i); v1[i] = *(const u32x4*)(r1 + 1280 + 8 * i); }
            } else {
#pragma unroll
                for (int i = 0; i < 4; ++i) { k0[i] = (u32x4){0u, 0u, 0u, 0u}; k1[i] = k0[i]; v0[i] = k0[i]; v1[i] = k0[i]; }
            }
#pragma unroll
            for (int i = 0; i < 4; ++i) {
                *(LAS u32x4*)(lds + kj0 * KS_STRIDE + (qtr * 32 + 8 * i) * 2) = k0[i];
                *(LAS u32x4*)(lds + (kj0 + 1) * KS_STRIDE + (qtr * 32 + 8 * i) * 2) = k1[i];
#pragma unroll
                for (int w = 0; w < 4; ++w) { const unsigned a = v0[i][w], c = v1[i][w]; const int hd = qtr * 32 + 8 * i + 2 * w;
                    *(LAS unsigned*)(lds + VT_OFF + hd * VT_STRIDE + kj0 * 2) = (a & 0xffffu) | (c << 16);
                    *(LAS unsigned*)(lds + VT_OFF + (hd + 1) * VT_STRIDE + kj0 * 2) = (a >> 16) | (c & 0xffff0000u); }
            }
        }
        __syncthreads();
#pragma unroll 1
        for (int pass = 0; pass < 2; ++pass) {
            const int task = wid + 8 * pass, r = task & 3, c = task >> 2, head = g * 4 + r;
            const int kt0 = (n == 0) ? (8 - 2 * c) : 0;
            bf16x8 qf[2][4];
#pragma unroll
            for (int qt = 0; qt < 2; ++qt) { const int i = 32 * c + 16 * qt + l15; const size_t tok = (size_t)b * SEQ + (size_t)((n * 128 + i) * d + e);
                const bf16_t* qr = Z + tok * ZP + head * 128 + quad * 8;
#pragma unroll
                for (int ks = 0; ks < 4; ++ks) qf[qt][ks] = *(const bf16x8*)(qr + ks * 32); }
            f32x4 sacc[10][2];
#pragma unroll
            for (int kt = 0; kt < 10; ++kt) { sacc[kt][0] = (f32x4){0.f, 0.f, 0.f, 0.f}; sacc[kt][1] = sacc[kt][0]; }
#pragma unroll
            for (int kt = 0; kt < 10; ++kt) if (kt >= kt0) {
#pragma unroll
                for (int ks = 0; ks < 4; ++ks) { const bf16x8 kf = *(const LAS bf16x8*)(lds + (32 * c + 16 * kt + l15) * KS_STRIDE + (ks * 32 + quad * 8) * 2);
                    sacc[kt][0] = MFMA16(kf, qf[0][ks], sacc[kt][0]); sacc[kt][1] = MFMA16(kf, qf[1][ks], sacc[kt][1]); }
            }
            const float SC = 0.08838834764831845f * 1.4426950408889634f;
            float mrow[2], lrow[2];
#pragma unroll
            for (int qt = 0; qt < 2; ++qt) { const int i = 32 * c + 16 * qt + l15; float mx = -__builtin_inff();
#pragma unroll
                for (int kt = 0; kt < 10; ++kt)
#pragma unroll
                    for (int j = 0; j < 4; ++j) { const int kj = 32 * c + 16 * kt + 4 * quad + j; const bool ok = (kj >= i) && (kj <= i + 128) && (n > 0 || kj >= 128);
                        const float s = ok ? sacc[kt][qt][j] * SC : -__builtin_inff(); sacc[kt][qt][j] = s; mx = fmaxf(mx, s); }
                mx = fmaxf(mx, __shfl_xor(mx, 16)); mx = fmaxf(mx, __shfl_xor(mx, 32));
                float l = 0.f;
#pragma unroll
                for (int kt = 0; kt < 10; ++kt)
#pragma unroll
                    for (int j = 0; j < 4; ++j) { const float pv = __builtin_amdgcn_exp2f(sacc[kt][qt][j] - mx); sacc[kt][qt][j] = pv; l += pv; }
                l += __shfl_xor(l, 16); l += __shfl_xor(l, 32);
                mrow[qt] = mx; lrow[qt] = l; }
            bf16x8 pf[5][2];
#pragma unroll
            for (int kp = 0; kp < 5; ++kp)
#pragma unroll
                for (int qt = 0; qt < 2; ++qt) { const f32x4 a = sacc[2 * kp][qt], c2 = sacc[2 * kp + 1][qt];
                    const u32x4 w = (u32x4){pk2(a[0], a[1]), pk2(a[2], a[3]), pk2(c2[0], c2[1]), pk2(c2[2], c2[3])}; pf[kp][qt] = __builtin_bit_cast(bf16x8, w); }
            f32x4 oacc[8][2];
#pragma unroll
            for (int ht = 0; ht < 8; ++ht) { oacc[ht][0] = (f32x4){0.f, 0.f, 0.f, 0.f}; oacc[ht][1] = oacc[ht][0]; }
#pragma unroll
            for (int kp = 0; kp < 5; ++kp) if (2 * kp >= kt0) {
#pragma unroll
                for (int ht = 0; ht < 8; ++ht) { const LAS unsigned char* vp = lds + VT_OFF + (16 * ht + l15) * VT_STRIDE + (32 * c + 32 * kp + 4 * quad) * 2;
                    const u32x2 lo = *(const LAS u32x2*)vp, hi = *(const LAS u32x2*)(vp + 32);
                    const bf16x8 vf = __builtin_bit_cast(bf16x8, ((u32x4){lo.x, lo.y, hi.x, hi.y}));
                    oacc[ht][0] = MFMA16(vf, pf[kp][0], oacc[ht][0]); oacc[ht][1] = MFMA16(vf, pf[kp][1], oacc[ht][1]); }
            }
#pragma unroll
            for (int qt = 0; qt < 2; ++qt) { const int i = 32 * c + 16 * qt + l15; const size_t tok = (size_t)b * SEQ + (size_t)((n * 128 + i) * d + e);
                const float inv = 1.0f / lrow[qt];
                bf16_t* op = (br == 0 ? Z + tok * ZP + NIN : OB12 + (size_t)b * SEQ * D + (size_t)(br - 1) * SEQ * QD + (tok - (size_t)b * SEQ) * QD) + head * 128 + 4 * quad;
#pragma unroll
                for (int ht = 0; ht < 8; ++ht) { const f32x4 o = oacc[ht][qt] * inv; *(u32x2*)(op + 16 * ht) = (u32x2){pk2(o.x, o.y), pk2(o.z, o.w)}; }
                if (quad == 0) LSE[((size_t)br * T + tok) * 8 + head] = mrow[qt] * 0.6931471805599453f + __logf(lrow[qt]); }
        }
    }
}

__device__ __forceinline__ void combine_phase(const bf16_t* Z, const bf16_t* OB12, const float* LSE, const float* convw, const float* ga, const float* gc, bf16_t* XN, int boff, int row0, int rstride, int nrows, int lane) {
    for (int kr = 0, t = row0; kr < nrows && t < T; ++kr, t += rstride) {
        const int s = t & (SEQ - 1);
        float av[2][8], cv[2][8]; float ssa = 0.f, ssc = 0.f;
#pragma unroll
        for (int j = 0; j < 2; ++j) { const int chunk = lane + 64 * j, col = chunk * 8, head = chunk >> 4;
            const float l0 = LSE[((size_t)0 * T + t) * 8 + head], l1 = LSE[((size_t)1 * T + t) * 8 + head], l2 = LSE[((size_t)2 * T + t) * 8 + head];
            const float mx = fmaxf(l0, fmaxf(l1, l2)); float w0 = __expf(l0 - mx), w1 = __expf(l1 - mx), w2 = __expf(l2 - mx); const float inv = 1.0f / (w0 + w1 + w2); w0 *= inv; w1 *= inv; w2 *= inv;
            const u32x4 o0 = *(const u32x4*)(Z + (size_t)t * ZP + NIN + col), o1 = *(const u32x4*)(OB12 + (size_t)(t >> 11) * SEQ * D + (size_t)s * QD + col), o2 = *(const u32x4*)(OB12 + (size_t)(t >> 11) * SEQ * D + (size_t)SEQ * QD + (size_t)s * QD + col);
#pragma unroll
            for (int w = 0; w < 4; ++w) { const float a0 = w0 * bflo(o0[w]) + w1 * bflo(o1[w]) + w2 * bflo(o2[w]), a1 = w0 * bfhi(o0[w]) + w1 * bfhi(o1[w]) + w2 * bfhi(o2[w]);
                av[j][2 * w] = a0; av[j][2 * w + 1] = a1; ssa += a0 * a0 + a1 * a1; } }
#pragma unroll
        for (int j = 0; j < 2; ++j) { const int ch = (lane + 64 * j) * 8; const bf16_t* zr = Z + (size_t)t * ZP;
            const u32x4 hc0 = *(const u32x4*)(zr + 1536 + ch), bg0 = *(const u32x4*)(zr + 2560 + ch), cg0 = *(const u32x4*)(zr + 3584 + ch);
            u32x4 hc1 = (u32x4){0u, 0u, 0u, 0u}, cg1 = hc1, hc2 = hc1, cg2 = hc1;
            if (s >= 1) { hc1 = *(const u32x4*)(zr - ZP + 1536 + ch); cg1 = *(const u32x4*)(zr - ZP + 3584 + ch); }
            if (s >= 2) { hc2 = *(const u32x4*)(zr - 2 * ZP + 1536 + ch); cg2 = *(const u32x4*)(zr - 2 * ZP + 3584 + ch); }
            float wk[3][8];
#pragma unroll
            for (int k = 0; k < 3; ++k) { const f32x4 a = *(const f32x4*)(convw + k * QD + ch), b2 = *(const f32x4*)(convw + k * QD + ch + 4);
                wk[k][0] = a.x; wk[k][1] = a.y; wk[k][2] = a.z; wk[k][3] = a.w; wk[k][4] = b2.x; wk[k][5] = b2.y; wk[k][6] = b2.z; wk[k][7] = b2.w; }
#pragma unroll
            for (int w = 0; w < 4; ++w) {
                const float y0 = wk[2][2 * w] * (bflo(cg0[w]) * bflo(hc0[w])) + wk[1][2 * w] * (bflo(cg1[w]) * bflo(hc1[w])) + wk[0][2 * w] * (bflo(cg2[w]) * bflo(hc2[w]));
                const float y1 = wk[2][2 * w + 1] * (bfhi(cg0[w]) * bfhi(hc0[w])) + wk[1][2 * w + 1] * (bfhi(cg1[w]) * bfhi(hc1[w])) + wk[0][2 * w + 1] * (bfhi(cg2[w]) * bfhi(hc2[w]));
                const float c0 = bflo(bg0[w]) * y0, c1 = bfhi(bg0[w]) * y1; cv[j][2 * w] = c0; cv[j][2 * w + 1] = c1; ssc += c0 * c0 + c1 * c1; } }
        const float ra = rsqrtf(wave_sum(ssa) * (1.f / QD) + EPS), rc = rsqrtf(wave_sum(ssc) * (1.f / QD) + EPS);
#pragma unroll
        for (int j = 0; j < 2; ++j) { const int col = (lane + 64 * j) * 8;
            const f32x4 g0 = *(const f32x4*)(ga + col), g1 = *(const f32x4*)(ga + col + 4), h0 = *(const f32x4*)(gc + col), h1 = *(const f32x4*)(gc + col + 4);
            u32x4 oa, oc;
            oa.x = pk2(av[j][0] * ra * g0.x, av[j][1] * ra * g0.y); oa.y = pk2(av[j][2] * ra * g0.z, av[j][3] * ra * g0.w); oa.z = pk2(av[j][4] * ra * g1.x, av[j][5] * ra * g1.y); oa.w = pk2(av[j][6] * ra * g1.z, av[j][7] * ra * g1.w);
            oc.x = pk2(cv[j][0] * rc * h0.x, cv[j][1] * rc * h0.y); oc.y = pk2(cv[j][2] * rc * h0.z, cv[j][3] * rc * h0.w); oc.z = pk2(cv[j][4] * rc * h1.x, cv[j][5] * rc * h1.y); oc.w = pk2(cv[j][6] * rc * h1.z, cv[j][7] * rc * h1.w);
            bf16_t* xo = XN + (size_t)t * D + (size_t)(t >> 11) * boff;
            *(u32x4*)(xo + col) = oa; *(u32x4*)(xo + QD + col) = oc; }
    }
}

#define XB_TMO      128
#define XB_XCNT(j)  (256  + 64 * (j))
#define XB_XSUB(j)  (1280 + 64 * (j))
#define XB_XGEN(j)  (2304 + 64 * (j))
#define XB_TOP      3328
#define XB_TOPGEN   3392
#define XCD_BAR_WORDS 3456
#define XB_SPIN_CAP (1u << 18)
__device__ __forceinline__ unsigned xb_ld(unsigned* p)              { return __hip_atomic_load(p, __ATOMIC_RELAXED, __HIP_MEMORY_SCOPE_AGENT); }
__device__ __forceinline__ unsigned xb_add(unsigned* p, unsigned v) { return __hip_atomic_fetch_add(p, v, __ATOMIC_RELAXED, __HIP_MEMORY_SCOPE_AGENT); }
__device__ __forceinline__ unsigned xb_xcc_id() { return (unsigned)__builtin_amdgcn_s_getreg((3 << 11) | 20) & 0xFu; }
#define XB_SPIN(cond, bar) do { unsigned _sp = 0; while (cond) { __builtin_amdgcn_s_sleep(1); \
    if ((++_sp & 255u) == 0u) { if (xb_ld(&(bar)[XB_TMO])) break; if (_sp > XB_SPIN_CAP) { atomicAdd(&(bar)[XB_TMO], 1u); break; } } } } while (0)
__device__ __forceinline__ void xcd_barrier_complete(unsigned* bar, unsigned x, unsigned& nloc, unsigned& nx) {
    const unsigned G = gridDim.x * gridDim.y * gridDim.z;
    unsigned sum, cnt, mine, sp = 0u;
    for (;;) {
        sum = 0u; cnt = 0u; mine = 0u;
#pragma unroll
        for (unsigned j = 0; j < 16; ++j) { const unsigned c = xb_ld(&bar[XB_XCNT(j)]); sum += c; cnt += (c > 0u) ? 1u : 0u; mine = (j == x) ? c : mine; }
        if (sum == G) break;
        __builtin_amdgcn_s_sleep(1);
        if ((++sp & 255u) == 0u) { if (xb_ld(&bar[XB_TMO])) break; if (sp > XB_SPIN_CAP) { atomicAdd(&bar[XB_TMO], 1u); break; } }
    }
    nloc = mine > 0u ? mine : 1u; nx = cnt > 0u ? cnt : 1u;
}
__device__ __forceinline__ void xcd_barrier(unsigned* bar, volatile LAS unsigned* st, int tid) {
    asm volatile("s_waitcnt vmcnt(0)" ::: "memory");
    __syncthreads();
    if (tid == 0) {
        const unsigned x = xb_xcc_id();
        __builtin_amdgcn_s_waitcnt(0);
        unsigned nloc = st[0], nx = st[1];
        if (nloc == 0u) { xcd_barrier_complete(bar, x, nloc, nx); st[0] = nloc; st[1] = nx; }
        const unsigned old = xb_add(&bar[XB_XSUB(x)], 1u);
        const unsigned gen = old / nloc;
        if (old + 1u == (gen + 1u) * nloc) {
            __builtin_amdgcn_fence(__ATOMIC_RELEASE, "agent");
            asm volatile("s_waitcnt vmcnt(0)" ::: "memory");
            const unsigned og = xb_add(&bar[XB_TOP], 1u);
            const unsigned tg = og / nx;
            if (og + 1u == (tg + 1u) * nx) xb_add(&bar[XB_TOPGEN], 1u);
            else XB_SPIN(xb_ld(&bar[XB_TOPGEN]) == tg, bar);
            __builtin_amdgcn_fence(__ATOMIC_ACQUIRE, "agent");
            xb_add(&bar[XB_XGEN(x)], 1u);
            asm volatile("s_waitcnt vmcnt(0)" ::: "memory");
        } else {
            XB_SPIN(xb_ld(&bar[XB_XGEN(x)]) == gen, bar);
            __builtin_amdgcn_fence(__ATOMIC_ACQUIRE, "agent");
            asm volatile("s_waitcnt vmcnt(0)" ::: "memory");
        }
    }
    __syncthreads();
}
#define XL_WORD(x) (4096 + 64 * (x))
__device__ __forceinline__ void xcc_local_barrier(unsigned* cnt, unsigned target, int tid) {
    asm volatile("s_waitcnt vmcnt(0)" ::: "memory");
    __syncthreads();
    if (tid == 0) {
        __builtin_amdgcn_s_waitcnt(0);
        (void)xb_add(cnt, 1u);
        unsigned sp = 0u;
        while (xb_ld(cnt) < target) { __builtin_amdgcn_s_sleep(1); if (++sp > (1u << 24)) break; }
        __builtin_amdgcn_fence(__ATOMIC_ACQUIRE, "agent");
        asm volatile("s_waitcnt vmcnt(0)" ::: "memory");
    }
    __syncthreads();
}
struct Ctx { int tid, lane, wave, G, bid, gw, ngw; };
__device__ __forceinline__ int make_tid(int wave_s) {
    int ln; asm volatile("v_mbcnt_lo_u32_b32 %0, -1, 0\n\tv_mbcnt_hi_u32_b32 %0, -1, %0" : "=&v"(ln));
    return wave_s * 64 + ln;
}
__device__ __forceinline__ Ctx make_ctx(int wave_s) {
    const int t = make_tid(wave_s);
    Ctx c; c.tid = t; c.lane = t & 63; c.wave = wave_s; c.G = gridDim.x; c.bid = blockIdx.x; c.gw = c.bid * NWAVES + c.wave; c.ngw = c.G * NWAVES; return c;
}
__device__ __forceinline__ const Params* get_params() {
    const Params* pp = (const Params*)__builtin_amdgcn_kernarg_segment_ptr(); asm volatile("" : "+s"(pp)); return pp;
}
__global__ void __launch_bounds__(NTHREADS) fwd_megakernel(Params p_unused) {
    extern __shared__ __attribute__((aligned(16))) unsigned char lds_raw[];
    LAS unsigned char* lds = (LAS unsigned char*)lds_raw;
    cg::grid_group grid = cg::this_grid();
    const int wave_s = __builtin_amdgcn_readfirstlane((int)threadIdx.x >> 6);
    volatile LAS unsigned* xst = (volatile LAS unsigned*)(lds + LDS_BYTES - 16);
    { unsigned* barp = (unsigned*)(get_params()->ws + WS_CTL); const unsigned xcc = xb_xcc_id();
      if (threadIdx.x == 0) { xst[0] = 0u; xst[1] = 0u; xst[2] = xb_add(&barp[XB_XCNT(xcc)], 1u); } }
    { const Params* pp = get_params(); const Ctx c = make_ctx(wave_s); prologue_phase(*pp, lds, c.gw, c.ngw, c.wave, c.lane); }
    __syncthreads();
    if (gridDim.y == 0x7fffu) grid.sync();
    xcd_barrier((unsigned*)(get_params()->ws + WS_CTL), xst, make_tid(wave_s));
    { unsigned* barp = (unsigned*)(get_params()->ws + WS_CTL);
      if (threadIdx.x == 0) { bool even = (gridDim.x == 256);
          for (unsigned j = 0; j < 16; ++j) { const unsigned cn = xb_ld(&barp[XB_XCNT(j)]); even = even && (j < 8 ? cn == 32u : cn == 0u); }
          xst[3] = even ? 1u : 0u; } }
    __syncthreads();
    const unsigned xcc_s = xb_xcc_id();
    const bool xlocal = __builtin_amdgcn_readfirstlane((int)xst[3]) != 0;
    const int vbid = xlocal ? (int)(__builtin_amdgcn_readfirstlane((int)xst[2]) * 8 + (int)xcc_s) : (int)blockIdx.x;
    const bool grouped = (gridDim.x == 256);
    const int vb_b = vbid & 7, vb_r = vbid >> 3;
    unsigned lk = 0u;
#define GRID_BAR() do { if (xlocal) { ++lk; xcc_local_barrier((unsigned*)(get_params()->ws + WS_CTL) + XL_WORD(xcc_s), 32u * lk, make_tid(wave_s)); } \
                        else xcd_barrier((unsigned*)(get_params()->ws + WS_CTL), xst, make_tid(wave_s)); } while (0)
#define ROW0(c) (grouped ? vb_b * SEQ + vb_r * 8 + (c).wave : (c).gw)
#define RSTRIDE(c) (grouped ? 256 : (c).ngw)
#define NROWS() (grouped ? 8 : T)
    unsigned nri = 0u;
#define DYN_WORD(i, b) (5120 + 16 * ((int)(i) * 8 + (b)))
#define NR_ARGS(c) ROW0(c), RSTRIDE(c), (grouped ? 6 : T), (grouped ? (unsigned*)(ws + WS_CTL) + DYN_WORD(nri, vb_b) : nullptr), vb_b * SEQ + 1536, 256, (c).lane
#pragma unroll 1
    for (int l = 0; l < DEPTH; ++l) {
#pragma unroll 1
        for (int f = 0; f < 2; ++f) {
            if (f == 1) {
                { const Params* pp = get_params(); unsigned char* ws = pp->ws; const int G = gridDim.x, bid = vbid;
                  pg8::Gemm g{(const bf16_t*)(ws + WS_XN), (const bf16_t*)(ws + WS_W + (size_t)l * SZ_LAYER + OFF_IN), T, NIN, D}; pg8::StaticOrder S; S.init(T, NIN, G, bid); pg8::EpiBf16 E{(bf16_t*)(ws + WS_BIG), ZP};
                  pg8::gemm_phase<pg8::EpiBf16, pg8::StaticOrder, true, true>(lds, g, S, E, make_tid(wave_s)); }
                GRID_BAR();
                { const Params* pp = get_params(); unsigned char* ws = pp->ws; const Ctx c = make_ctx(wave_s);
                  attn_phase(lds, (bf16_t*)(ws + WS_BIG), (bf16_t*)(ws + WS_HF + (size_t)T * D * 2), (float*)(ws + WS_LSE), grouped ? (vb_b * 2 + (vb_r & 1)) * 48 + (vb_r >> 1) : c.bid, grouped ? 16 : c.G, grouped ? 3 : 768, c.tid); }
                GRID_BAR();
                { const Params* pp = get_params(); unsigned char* ws = pp->ws; const Ctx c = make_ctx(wave_s);
                  combine_phase((const bf16_t*)(ws + WS_BIG), (const bf16_t*)(ws + WS_HF + (size_t)T * D * 2), (const float*)(ws + WS_LSE), pp->in[7] + (size_t)l * 3 * QD, pp->in[8] + (size_t)l * QD, pp->in[9] + (size_t)l * QD,
                                (bf16_t*)(ws + WS_HF), 0, ROW0(c), RSTRIDE(c), NROWS(), c.lane); }
                GRID_BAR();
                { const Params* pp = get_params(); unsigned char* ws = pp->ws; const int G = gridDim.x, bid = vbid;
                  pg8::Gemm g{(const bf16_t*)(ws + WS_HF), (const bf16_t*)(ws + WS_W + (size_t)l * SZ_LAYER + OFF_OUT), T, D, D}; pg8::StaticOrder S; S.init(T, D, G, bid); pg8::EpiBf16 E{(bf16_t*)(ws + WS_HF + (size_t)T * D * 2), D};
                  pg8::gemm_phase<pg8::EpiBf16, pg8::StaticOrder, true, true>(lds, g, S, E, make_tid(wave_s)); }
                GRID_BAR();
                { const Params* pp = get_params(); unsigned char* ws = pp->ws; const Ctx c = make_ctx(wave_s);
                  normres_phase((const bf16_t*)(ws + WS_HF + (size_t)T * D * 2), nullptr, pp->in[5] + (size_t)l * D, (bf16_t*)(ws + WS_XN), (bf16_t*)(ws + WS_LO), (float*)(ws + WS_RS), nullptr, pp->in[11] + (size_t)l * D, 1.0f, pp->in[12] + (size_t)l * D, NR_ARGS(c)); ++nri; }
                GRID_BAR();
            }
            { const Params* pp = get_params(); unsigned char* ws = pp->ws; const int G = gridDim.x, bid = vbid;
              pg8::Gemm g{(const bf16_t*)(ws + WS_XN), (const bf16_t*)(ws + WS_W + (size_t)l * SZ_LAYER + (f ? OFF_GU2 : OFF_GU1)), T, NGU, D}; pg8::StaticOrder S; S.init(T, NGU, G, bid); pg8::EpiSwiGLU E{(bf16_t*)(ws + WS_BIG), FF};
              pg8::gemm_phase<pg8::EpiSwiGLU, pg8::StaticOrder, true, true>(lds, g, S, E, make_tid(wave_s)); }
            GRID_BAR();
            { const Params* pp = get_params(); unsigned char* ws = pp->ws; const int G = gridDim.x, bid = vbid;
              pg8::Gemm g{(const bf16_t*)(ws + WS_BIG), (const bf16_t*)(ws + WS_W + (size_t)l * SZ_LAYER + (f ? OFF_D2 : OFF_D1)), T, D, FF}; pg8::StaticOrder S; S.init(T, D, G, bid); pg8::EpiBf16 E{(bf16_t*)(ws + WS_HF), D};
              pg8::gemm_phase<pg8::EpiBf16, pg8::StaticOrder, true, true>(lds, g, S, E, make_tid(wave_s)); }
            GRID_BAR();
            { const Params* pp = get_params(); unsigned char* ws = pp->ws; const Ctx c = make_ctx(wave_s);
              const float* gpost = (f ? pp->in[15] : pp->in[4]) + (size_t)l * D;
              const float* gpre = f ? (l + 1 < DEPTH ? pp->in[1] + (size_t)(l + 1) * D : nullptr) : pp->in[5] + (size_t)l * D;
              const float* gprev = (f ? pp->in[12] : pp->in[1]) + (size_t)l * D;
              const float* xsrc = (l == 0 && f == 0) ? pp->in[0] : nullptr;
              float* xdst = (l == DEPTH - 1 && f == 1) ? pp->out : nullptr;
              normres_phase((const bf16_t*)(ws + WS_HF), xsrc, gprev, (bf16_t*)(ws + WS_XN), (bf16_t*)(ws + WS_LO), (float*)(ws + WS_RS), xdst, gpost, 0.5f, gpre, NR_ARGS(c)); ++nri; }
            if (!(l == DEPTH - 1 && f == 1)) GRID_BAR();
        }
    }
}

extern "C" void kernel_launch(void* const* d_in, const int* in_sizes, int n_in, void* d_out, int out_size, void* d_ws, size_t ws_size, hipStream_t stream) {
    static int grid_blocks = 0;
    if (grid_blocks == 0) {
        if (n_in != 16 || out_size != T * D || ws_size < WS_END) { fprintf(stderr, "kernel_launch: unexpected shapes (n_in %d out %d ws %zu need %zu)\n", n_in, out_size, ws_size, (size_t)WS_END); grid_blocks = -1; return; }
        int dev = 0, cus = 0, per_cu = 0;
        hipGetDevice(&dev);
        hipDeviceGetAttribute(&cus, hipDeviceAttributeMultiprocessorCount, dev);
        if (hipFuncSetAttribute((const void*)fwd_megakernel, hipFuncAttributeMaxDynamicSharedMemorySize, LDS_BYTES) != hipSuccess) { fprintf(stderr, "kernel_launch: hipFuncSetAttribute failed\n"); }
        if (hipOccupancyMaxActiveBlocksPerMultiprocessor(&per_cu, (const void*)fwd_megakernel, NTHREADS, LDS_BYTES) != hipSuccess || per_cu < 1) { fprintf(stderr, "kernel_launch: occupancy query gave %d\n", per_cu); per_cu = 1; }
        (void)hipGetLastError();
        grid_blocks = cus * 1;
        if (grid_blocks <= 0) grid_blocks = 256;
    }
    if (grid_blocks < 0) return;
    Params p{};
    for (int i = 0; i < 16; ++i) p.in[i] = (const float*)d_in[i];
    p.out = (float*)d_out; p.ws = (unsigned char*)d_ws;
    if (hipMemsetAsync((unsigned char*)d_ws + WS_CTL, 0, 32768, stream) != hipSuccess) fprintf(stderr, "kernel_launch: memset of barrier words failed\n");
    void* args[] = {&p};
    hipError_t e = hipLaunchCooperativeKernel((const void*)fwd_megakernel, dim3(grid_blocks), dim3(NTHREADS), args, LDS_BYTES, stream);
    if (e != hipSuccess) fprintf(stderr, "cooperative launch failed: %s (grid %d)\n", hipGetErrorString(e), grid_blocks);
}
```

```cpp
#include <hip/hip_runtime.h>
#include <hip/hip_cooperative_groups.h>
#include <cstdio>
#include <cstdint>
namespace pg8 {
#define PG8_LAS __attribute__((address_space(3)))
typedef unsigned short bf16_t;
typedef short bf16x8 __attribute__((ext_vector_type(8)));
typedef float f32x4 __attribute__((ext_vector_type(4)));
typedef unsigned u32x4 __attribute__((ext_vector_type(4)));
constexpr int BM = 256, BK = 64, HALF = 128, HTB = HALF * BK * 2  , STAGE_BYTES = 8 * HTB, NXCD = 8, WGM = 8;

__host__ __device__ __forceinline__ int lds_byte(int r, int c) { const int st = (r >> 4) * 2 + (c >> 5), rr = r & 15, cc = c & 31, ob = rr * 64 + cc * 2; return st * 1024 + (ob ^ (((ob >> 9) & 1) << 5)); }
__host__ __device__ __forceinline__ void stage_rc(int b, int& R, int& C) { const int st = b / 1024, sb = b % 1024, swz = sb ^ (((sb >> 9) & 1) << 5); R = (st >> 1) * 16 + swz / 64; C = (st & 1) * 32 + (swz % 64) / 2; }
__host__ __device__ __forceinline__ int perm32(int rho) { const int n = rho >> 4, i = rho & 15; return 8 * (i >> 2) + 4 * n + (i & 3); }

struct Unit { int pm, pn; };
struct Gemm { const bf16_t* A; const bf16_t* Bt; int M, N, K; };

struct StaticOrder {
    int nM, nN, nwg, G, c;
    __host__ __device__ void init(int M, int N, int G_, int c_) { nM = M / BM; nN = N / BM; nwg = nM * nN; G = G_; c = c_; }
    __host__ __device__ bool next(int i, Unit& u) const {
        const long L = (long)i * G + c; if (L >= nwg) return false;
        int wgid = (int)L; { const int q = nwg / NXCD, r = nwg % NXCD, xcd = wgid % NXCD, off = wgid / NXCD; wgid = (xcd < r ? xcd * (q + 1) : r * (q + 1) + (xcd - r) * q) + off; }
        const int nig = WGM * nN, gid = wgid / nig, fm = gid * WGM, gsz = (nM - fm) < WGM ? (nM - fm) : WGM;
        u.pm = fm + ((wgid % nig) % gsz); u.pn = (wgid % nig) / gsz; return true;
    }
    __device__ __forceinline__ void a_ready(const Unit&) const {}
    __device__ __forceinline__ void done(const Unit&) const {}
};
__device__ __forceinline__ unsigned cvt_pk_bf16(float lo, float hi) { unsigned r; asm volatile("v_cvt_pk_bf16_f32 %0, %1, %2" : "=v"(r) : "v"(lo), "v"(hi)); return r; }
struct EpiF32 {
    static constexpr bool PERM = false, AFTER_DRAIN = false;
    float* C; int ldc;
    __device__ __forceinline__ void operator()(const f32x4 (&acc)[2][2][4][2], const Unit& u, int wr, int wc, int fr, int fq) const {
        const int row0 = u.pm * BM + wr * 64 + fr, col0 = u.pn * BM + wc * 32 + 4 * fq;
#pragma unroll
        for (int ai = 0; ai < 2; ++ai)
#pragma unroll
            for (int m = 0; m < 4; ++m) { float* rowp = C + (size_t)(row0 + ai * HALF + m * 16) * ldc + col0;
#pragma unroll
                for (int bj = 0; bj < 2; ++bj)
#pragma unroll
                    for (int n = 0; n < 2; ++n) *(f32x4*)(rowp + bj * HALF + n * 16) = acc[ai][bj][m][n]; }
    }
};
struct EpiBf16 {
    static constexpr bool PERM = true, AFTER_DRAIN = false;
    bf16_t* O; int ldc;
    __device__ __forceinline__ void operator()(const f32x4 (&acc)[2][2][4][2], const Unit& u, int wr, int wc, int fr, int fq) const {
        const int row0 = u.pm * BM + wr * 64 + fr, col0 = u.pn * BM + wc * 32 + 8 * fq;
#pragma unroll
        for (int ai = 0; ai < 2; ++ai)
#pragma unroll
            for (int m = 0; m < 4; ++m) { bf16_t* rowp = O + (size_t)(row0 + ai * HALF + m * 16) * ldc + col0;
#pragma unroll
                for (int bj = 0; bj < 2; ++bj) { const f32x4 v0 = acc[ai][bj][m][0], v1 = acc[ai][bj][m][1];
                    u32x4 w; w.x = cvt_pk_bf16(v0[0], v0[1]); w.y = cvt_pk_bf16(v0[2], v0[3]); w.z = cvt_pk_bf16(v1[0], v1[1]); w.w = cvt_pk_bf16(v1[2], v1[3]);
                    *(u32x4*)(rowp + bj * HALF) = w; } }
    }
};
__device__ __forceinline__ float silu_mul(float g, float u) { return g * u * __builtin_amdgcn_rcpf(1.0f + __builtin_amdgcn_exp2f(g * -1.4426950408889634f)); }
struct EpiSwiGLU {
    static constexpr bool PERM = true, AFTER_DRAIN = false;
    bf16_t* O; int ldc;
    __device__ __forceinline__ void operator()(const f32x4 (&acc)[2][2][4][2], const Unit& u, int wr, int wc, int fr, int fq) const {
        const int row0 = u.pm * BM + wr * 64 + fr, col0 = u.pn * HALF + wc * 32 + 8 * fq;
#pragma unroll
        for (int ai = 0; ai < 2; ++ai)
#pragma unroll
            for (int m = 0; m < 4; ++m) { bf16_t* rowp = O + (size_t)(row0 + ai * HALF + m * 16) * ldc + col0;
                const f32x4 g0 = acc[ai][0][m][0], g1 = acc[ai][0][m][1], u0 = acc[ai][1][m][0], u1 = acc[ai][1][m][1];
                u32x4 w; w.x = cvt_pk_bf16(silu_mul(g0[0], u0[0]), silu_mul(g0[1], u0[1])); w.y = cvt_pk_bf16(silu_mul(g0[2], u0[2]), silu_mul(g0[3], u0[3]));
                w.z = cvt_pk_bf16(silu_mul(g1[0], u1[0]), silu_mul(g1[1], u1[1])); w.w = cvt_pk_bf16(silu_mul(g1[2], u1[2]), silu_mul(g1[3], u1[3]));
                *(u32x4*)rowp = w; }
    }
};

template <class Epi, class Sched, bool ALIGN_EPI = false, bool SP2 = false>
__device__ __forceinline__ void gemm_phase(PG8_LAS unsigned char* lds, const Gemm g, const Sched& S, const Epi& E, int tid_in) {
    int tid_l = tid_in; asm volatile("" : "+v"(tid_l));
    const int tid = tid_l, wid = __builtin_amdgcn_readfirstlane(tid >> 6), lane = tid & 63, wr = wid >> 2, wc = wid & 3, fr = lane & 15, fq = lane >> 4;
    const int K = g.K, nt = K / BK;
    unsigned voffA[2], voffB[2];
#pragma unroll
    for (int i = 0; i < 2; ++i) { int R, C; stage_rc(tid * 16 + i * 8192, R, C); const int Rb = Epi::PERM ? ((R & ~31) + perm32(R & 31)) : R;
        voffA[i] = (unsigned)(R * K + C) * 2u; voffB[i] = (unsigned)(Rb * K + C) * 2u; }
    const size_t kstep = (size_t)(BK * 2);
    const size_t hstep = (size_t)HALF * K * 2;
    const size_t tstep = 2 * hstep;
    const unsigned ldsw = (unsigned)wid * 1024u;
    const int aoff = lds_byte(wr * 64 + fr, fq * 8), boff = lds_byte(wc * 32 + fr, fq * 8);
#define PG8_SA(b, h) (((b) * 2 + (h)) * HTB)
#define PG8_SB(b, h) ((4 + (b) * 2 + (h)) * HTB)
#define PG8_STAGE(bufoff, gbase, voff) do { _Pragma("unroll") for (int _i = 0; _i < 2; ++_i) \
        __builtin_amdgcn_global_load_lds((const unsigned*)((const char*)(gbase) + (voff)[_i]), (PG8_LAS unsigned*)(lds + (bufoff) + ldsw + _i * 8192), 16, 0, 0); } while (0)
#define PG8_LDA(dst, b, h) do { _Pragma("unroll") for (int m = 0; m < 4; ++m) _Pragma("unroll") for (int k = 0; k < 2; ++k) dst[m][k] = *(const PG8_LAS bf16x8*)(lds + PG8_SA(b, h) + aoff + m * 2048 + k * 1024); } while (0)
#define PG8_LDB(dst, b, h) do { _Pragma("unroll") for (int n = 0; n < 2; ++n) _Pragma("unroll") for (int k = 0; k < 2; ++k) dst[n][k] = *(const PG8_LAS bf16x8*)(lds + PG8_SB(b, h) + boff + n * 2048 + k * 1024); } while (0)
#define PG8_MMA(ai, bj, At, Bt) do { __builtin_amdgcn_s_setprio(1); _Pragma("unroll") for (int m = 0; m < 4; ++m) _Pragma("unroll") for (int n = 0; n < 2; ++n) _Pragma("unroll") for (int k = 0; k < 2; ++k) \
        acc[ai][bj][m][n] = __builtin_amdgcn_mfma_f32_16x16x32_bf16(Bt[n][k], At[m][k], acc[ai][bj][m][n], 0, 0, 0); __builtin_amdgcn_s_setprio(0); } while (0)
#define PG8_WAIT_V(n) asm volatile("s_waitcnt vmcnt(" #n ")" ::: "memory")
#define PG8_WAIT_L(n) asm volatile("s_waitcnt lgkmcnt(" #n ")" ::: "memory")
#define PG8_BAR __builtin_amdgcn_s_barrier()
#define PG8_SCHED __builtin_amdgcn_sched_barrier(0)
    Unit cur, nxt; int ui = 0;
    if (!S.next(0, cur)) return;
    f32x4 acc[2][2][4][2];
#pragma unroll
    for (int a = 0; a < 2; ++a)
#pragma unroll
        for (int b = 0; b < 2; ++b)
#pragma unroll
            for (int m = 0; m < 4; ++m)
#pragma unroll
                for (int n = 0; n < 2; ++n) acc[a][b][m][n] = (f32x4){0.f, 0.f, 0.f, 0.f};
    bf16x8 At[4][2], B0[2][2], B1[2][2];
    const char* cA = (const char*)g.A + (size_t)cur.pm * tstep; const char* cB = (const char*)g.Bt + (size_t)cur.pn * tstep;
    S.a_ready(cur);
    if constexpr (SP2) {
        PG8_STAGE(PG8_SB(0, 0), cB, voffB); PG8_STAGE(PG8_SB(0, 1), cB + hstep, voffB); PG8_STAGE(PG8_SA(0, 0), cA, voffA); PG8_STAGE(PG8_SA(0, 1), cA + hstep, voffA);
        if (wr == 1) PG8_BAR;
        PG8_WAIT_V(2); PG8_BAR;
        PG8_STAGE(PG8_SB(1, 0), cB + kstep, voffB); PG8_STAGE(PG8_SA(1, 0), cA + kstep, voffA); PG8_STAGE(PG8_SB(1, 1), cB + hstep + kstep, voffB);
        PG8_WAIT_V(6); PG8_BAR;
    } else {
        PG8_STAGE(PG8_SB(0, 0), cB, voffB); PG8_STAGE(PG8_SA(0, 0), cA, voffA); PG8_STAGE(PG8_SB(0, 1), cB + hstep, voffB); PG8_STAGE(PG8_SA(0, 1), cA + hstep, voffA);
        if (wr == 1) PG8_BAR;
        PG8_WAIT_V(4); PG8_BAR;
        PG8_STAGE(PG8_SB(1, 0), cB + kstep, voffB); PG8_STAGE(PG8_SA(1, 0), cA + kstep, voffA); PG8_STAGE(PG8_SB(1, 1), cB + hstep + kstep, voffB);
        PG8_WAIT_V(6); PG8_BAR;
    }
    for (;;) {
        const bool has_next = S.next(ui + 1, nxt);
        const char* nA = has_next ? (const char*)g.A + (size_t)nxt.pm * tstep : cA; const char* nB = has_next ? (const char*)g.Bt + (size_t)nxt.pn * tstep : cB;
        for (int t = 0; t < nt; t += 2) {
            const bool last = (t == nt - 2);
            const char* a1 = cA + (size_t)(t + 1) * kstep;
            const char* a2 = last ? nA : cA + (size_t)(t + 2) * kstep; const char* b2 = last ? nB : cB + (size_t)(t + 2) * kstep;
            const char* a3 = a2 + kstep; const char* b3 = b2 + kstep;
            if (last && has_next) S.a_ready(nxt);
            if constexpr (SP2) {
            PG8_LDB(B0, 0, 0); PG8_LDB(B1, 0, 1); PG8_SCHED; PG8_LDA(At, 0, 0); PG8_STAGE(PG8_SA(1, 1), a1 + hstep, voffA);
            PG8_WAIT_V(8); PG8_WAIT_L(0); PG8_BAR; PG8_MMA(0, 0, At, B0); PG8_MMA(0, 1, At, B1); PG8_BAR; PG8_SCHED;
            PG8_LDA(At, 0, 1); PG8_STAGE(PG8_SB(0, 0), b2, voffB); PG8_STAGE(PG8_SB(0, 1), b2 + hstep, voffB); PG8_STAGE(PG8_SA(0, 0), a2, voffA);
            PG8_WAIT_V(8); PG8_WAIT_L(0); PG8_BAR; PG8_MMA(1, 0, At, B0); PG8_MMA(1, 1, At, B1); PG8_BAR; PG8_SCHED;
            PG8_LDB(B0, 1, 0); PG8_LDB(B1, 1, 1); PG8_SCHED; PG8_LDA(At, 1, 0); PG8_STAGE(PG8_SA(0, 1), a2 + hstep, voffA);
            PG8_WAIT_V(8); PG8_WAIT_L(0); PG8_BAR; PG8_MMA(0, 0, At, B0); PG8_MMA(0, 1, At, B1); PG8_BAR; PG8_SCHED;
            PG8_LDA(At, 1, 1); PG8_STAGE(PG8_SB(1, 0), b3, voffB); PG8_STAGE(PG8_SB(1, 1), b3 + hstep, voffB); PG8_STAGE(PG8_SA(1, 0), a3, voffA);
            PG8_WAIT_V(8); PG8_WAIT_L(0); PG8_BAR; PG8_MMA(1, 0, At, B0); PG8_MMA(1, 1, At, B1); PG8_BAR; PG8_SCHED;
            } else {
            PG8_LDB(B0, 0, 0); PG8_SCHED; PG8_LDA(At, 0, 0); PG8_STAGE(PG8_SA(1, 1), a1 + hstep, voffA);
            PG8_WAIT_L(8); PG8_BAR; PG8_WAIT_L(0); PG8_MMA(0, 0, At, B0); PG8_BAR; PG8_SCHED;
            PG8_LDB(B1, 0, 1); PG8_STAGE(PG8_SB(0, 0), b2, voffB);
            PG8_BAR; PG8_WAIT_L(0); PG8_MMA(0, 1, At, B1); PG8_BAR;
            PG8_LDA(At, 0, 1); PG8_STAGE(PG8_SA(0, 0), a2, voffA);
            PG8_BAR; PG8_WAIT_L(0); PG8_MMA(1, 0, At, B0); PG8_BAR; PG8_SCHED;
            PG8_STAGE(PG8_SB(0, 1), b2 + hstep, voffB);
            PG8_WAIT_V(6); PG8_BAR; PG8_MMA(1, 1, At, B1); PG8_BAR;
            PG8_LDB(B0, 1, 0); PG8_SCHED; PG8_LDA(At, 1, 0); PG8_STAGE(PG8_SA(0, 1), a2 + hstep, voffA);
            PG8_WAIT_L(8); PG8_BAR; PG8_WAIT_L(0); PG8_MMA(0, 0, At, B0); PG8_BAR; PG8_SCHED;
            PG8_LDB(B1, 1, 1); PG8_STAGE(PG8_SB(1, 0), b3, voffB);
            PG8_BAR; PG8_WAIT_L(0); PG8_MMA(0, 1, At, B1); PG8_BAR;
            PG8_LDA(At, 1, 1); PG8_STAGE(PG8_SA(1, 0), a3, voffA);
            PG8_BAR; PG8_WAIT_L(0); PG8_MMA(1, 0, At, B0); PG8_BAR; PG8_SCHED;
            PG8_STAGE(PG8_SB(1, 1), b3 + hstep, voffB);
            PG8_WAIT_V(6); PG8_BAR; PG8_MMA(1, 1, At, B1); PG8_BAR;
            }
        }
        if constexpr (ALIGN_EPI) { if (wr == 0) PG8_BAR; }
        if constexpr (!Epi::AFTER_DRAIN) { E(acc, cur, wr, wc, fr, fq); S.done(cur); }
        if (!has_next) break;
#pragma unroll
        for (int a = 0; a < 2; ++a)
#pragma unroll
            for (int b = 0; b < 2; ++b)
#pragma unroll
                for (int m = 0; m < 4; ++m)
#pragma unroll
                    for (int n = 0; n < 2; ++n) acc[a][b][m][n] = (f32x4){0.f, 0.f, 0.f, 0.f};
        cur = nxt; cA = nA; cB = nB; ++ui;
        if constexpr (ALIGN_EPI) { if (wr == 1) PG8_BAR; }
    }
    PG8_WAIT_V(0);
    if constexpr (!ALIGN_EPI) { if (wr == 0) PG8_BAR; }
    PG8_BAR;
    if constexpr (Epi::AFTER_DRAIN) { E.fused(acc, cur, wr, wc, fr, fq, lds, wid, lane); S.done(cur); }
#undef PG8_SA
#undef PG8_SB
#undef PG8_STAGE
#undef PG8_LDA
#undef PG8_LDB
#undef PG8_MMA
#undef PG8_WAIT_V
#undef PG8_WAIT_L
#undef PG8_BAR
#undef PG8_SCHED
}
}
namespace cg = cooperative_groups;
#define LAS __attribute__((address_space(3)))
typedef unsigned short bf16_t;
typedef short bf16x8 __attribute__((ext_vector_type(8)));
typedef float f32x4 __attribute__((ext_vector_type(4)));
typedef unsigned u32x4 __attribute__((ext_vector_type(4)));
typedef unsigned u32x2 __attribute__((ext_vector_type(2)));
typedef __bf16 bf16x2_n __attribute__((ext_vector_type(2)));
typedef float f32x2 __attribute__((ext_vector_type(2)));

constexpr int T = 16384, SEQ = 2048, D = 2048, FF = 5632, NGU = 2 * FF, NIN = 4608, QD = 1024, DEPTH = 2;
constexpr int ZP = FF;
constexpr float EPS = 1e-6f;
constexpr int NTHREADS = 512, NWAVES = 8;
constexpr int LDS_BYTES = 144 * 1024;
constexpr size_t SZ_GU = (size_t)NGU * D * 2, SZ_DN = (size_t)D * FF * 2, SZ_IN = (size_t)NIN * D * 2, SZ_OUT = (size_t)D * D * 2;
constexpr size_t OFF_GU1 = 0, OFF_D1 = OFF_GU1 + SZ_GU, OFF_IN = OFF_D1 + SZ_DN, OFF_OUT = OFF_IN + SZ_IN, OFF_GU2 = OFF_OUT + SZ_OUT, OFF_D2 = OFF_GU2 + SZ_GU, SZ_LAYER = OFF_D2 + SZ_DN;
constexpr size_t WS_W = 0, WS_XN = WS_W + DEPTH * SZ_LAYER, WS_BIG = WS_XN + (size_t)T * D * 2, WS_HF = WS_BIG + (size_t)T * FF * 2, WS_CTL = WS_HF + (size_t)T * D * 4, WS_LSE = WS_CTL + 32768, WS_RS = WS_LSE + (size_t)3 * T * 8 * 4, WS_LO = WS_RS + (size_t)T * 4, WS_END = WS_LO + (size_t)T * D * 2;
constexpr size_t OB_STRIDE = (size_t)T * QD;
constexpr size_t LSE_OFF = 3 * OB_STRIDE * 2;

struct Params { const float* in[16]; float* out; unsigned char* ws; };

__device__ __forceinline__ float wave_sum(float v) {
#pragma unroll
    for (int o = 1; o < 64; o <<= 1) v += __shfl_xor(v, o);
    return v;
}
__device__ __forceinline__ unsigned pk2(float lo, float hi) {
    const bf16x2_n r = __builtin_convertvector((f32x2){lo, hi}, bf16x2_n);
    return __builtin_bit_cast(unsigned, r);
}
__device__ __forceinline__ float bflo(unsigned w) { return __uint_as_float(w << 16); }
__device__ __forceinline__ float bfhi(unsigned w) { return __uint_as_float(w & 0xffff0000u); }
__device__ __forceinline__ float dot4(f32x4 a) { return (a.x * a.x + a.y * a.y) + (a.z * a.z + a.w * a.w); }

__device__ __forceinline__ void transpose_item(const float* W, int K, int N, bf16_t* WT, bool gu, LAS unsigned* scr, int item, int lane) {
    const int nblk = N / 64, kb = item / nblk, nb = item - kb * nblk, k0 = 64 * kb, n0 = 64 * nb;
    const int n4 = lane & 15, kq = lane >> 4;
    const float* src = W + (size_t)(k0 + 2 * kq) * N + n0 + 4 * n4;
    f32x4 L0[8], L1[8];
#pragma unroll
    for (int i = 0; i < 8; ++i) { L0[i] = *(const f32x4*)(src + (size_t)(8 * i) * N); L1[i] = *(const f32x4*)(src + (size_t)(8 * i + 1) * N); }
#pragma unroll
    for (int i = 0; i < 8; ++i) { const int kp = 4 * i + kq;
#pragma unroll
        for (int j = 0; j < 4; ++j) scr[(4 * n4 + j) * 33 + kp] = pk2(L0[i][j], L1[i][j]); }
    asm volatile("s_waitcnt lgkmcnt(0)" ::: "memory");
    int row0 = n0;
    if (gu) { const int up = n0 >= FF, nn = up ? n0 - FF : n0; row0 = 256 * (nn >> 7) + (up ? 128 : 0) + (nn & 127); }
    const int c = lane & 7;
#pragma unroll
    for (int j = 0; j < 8; ++j) { const int n = (lane >> 3) + 8 * j; const LAS unsigned* s = scr + n * 33 + 4 * c;
        u32x4 o; o.x = s[0]; o.y = s[1]; o.z = s[2]; o.w = s[3];
        *(u32x4*)(WT + (size_t)(row0 + n) * K + k0 + 8 * c) = o; }
    asm volatile("s_waitcnt lgkmcnt(0)" ::: "memory");
}
constexpr int IT_GU = (D / 64) * (NGU / 64), IT_DN = (FF / 64) * (D / 64), IT_IN = (D / 64) * (NIN / 64), IT_OUT = (D / 64) * (D / 64);
constexpr int IT_LAYER = 2 * IT_GU + 2 * IT_DN + IT_IN + IT_OUT;

__device__ __forceinline__ void prologue_phase(const Params& p, LAS unsigned char* lds, int gw, int ngw, int wave, int lane) {
    LAS unsigned* scr = (LAS unsigned*)(lds + wave * 16384);
    unsigned char* wsw = p.ws + WS_W;
    for (int it = gw; it < DEPTH * IT_LAYER; it += ngw) {
        const int l = it / IT_LAYER; int r = it - l * IT_LAYER;
        unsigned char* wl = wsw + (size_t)l * SZ_LAYER;
        if (r < IT_GU) { transpose_item(p.in[2] + (size_t)l * D * NGU, D, NGU, (bf16_t*)(wl + OFF_GU1), true, scr, r, lane); continue; } r -= IT_GU;
        if (r < IT_DN) { transpose_item(p.in[3] + (size_t)l * FF * D, FF, D, (bf16_t*)(wl + OFF_D1), false, scr, r, lane); continue; } r -= IT_DN;
        if (r < IT_IN) { transpose_item(p.in[6] + (size_t)l * D * NIN, D, NIN, (bf16_t*)(wl + OFF_IN), false, scr, r, lane); continue; } r -= IT_IN;
        if (r < IT_OUT) { transpose_item(p.in[10] + (size_t)l * D * D, D, D, (bf16_t*)(wl + OFF_OUT), false, scr, r, lane); continue; } r -= IT_OUT;
        if (r < IT_GU) { transpose_item(p.in[13] + (size_t)l * D * NGU, D, NGU, (bf16_t*)(wl + OFF_GU2), true, scr, r, lane); continue; } r -= IT_GU;
        transpose_item(p.in[14] + (size_t)l * FF * D, FF, D, (bf16_t*)(wl + OFF_D2), false, scr, r, lane);
    }
    const float* x = p.in[0]; const f32x4* g4 = (const f32x4*)p.in[1]; bf16_t* XN = (bf16_t*)(p.ws + WS_XN);
    for (int row = gw; row < T; row += ngw) {
        const f32x4* xr = (const f32x4*)(x + (size_t)row * D) + lane; f32x4 v[8]; float ss = 0.f;
#pragma unroll
        for (int j = 0; j < 8; ++j) { v[j] = xr[64 * j]; ss += dot4(v[j]); }
        const float rs = rsqrtf(wave_sum(ss) * (1.f / D) + EPS);
        u32x2* o = (u32x2*)(XN + (size_t)row * D) + lane;
#pragma unroll
        for (int j = 0; j < 8; ++j) { const f32x4 y = v[j] * rs * g4[lane + 64 * j]; o[64 * j] = (u32x2){pk2(y.x, y.y), pk2(y.z, y.w)}; }
    }
}

__device__ __forceinline__ f32x4 bf4lo(u32x4 w) { return (f32x4){bflo(w.x), bfhi(w.x), bflo(w.y), bfhi(w.y)}; }
__device__ __forceinline__ f32x4 bf4hi(u32x4 w) { return (f32x4){bflo(w.z), bfhi(w.z), bflo(w.w), bfhi(w.w)}; }
__device__ __forceinline__ f32x4 rcp4(f32x4 g) { return (f32x4){__builtin_amdgcn_rcpf(g.x), __builtin_amdgcn_rcpf(g.y), __builtin_amdgcn_rcpf(g.z), __builtin_amdgcn_rcpf(g.w)}; }
__device__ __forceinline__ void normres_phase(const bf16_t* hf, const float* xsrc, const float* gprev, bf16_t* HI, bf16_t* LO, float* RS, float* xdst, const float* gpost, float w, const float* gpre,
                                              int row0, int rstride, int nrows, unsigned* ctr, int poolbase, int npool, int lane) {
    const int nstat = (nrows + 1) >> 1; unsigned vnext = 0u;
    for (int trip = 0; ; ++trip) {
        int row, rowb; bool two;
        if (trip < nstat) {
            row = row0 + 2 * trip * rstride; if (row >= T) break;
            two = (2 * trip + 1 < nrows) && (row + rstride < T); rowb = two ? row + rstride : row;
            if (ctr != nullptr && trip == nstat - 1 && lane == 0) vnext = __hip_atomic_fetch_add(ctr, 1u, __ATOMIC_RELAXED, __HIP_MEMORY_SCOPE_AGENT);
        } else {
            if (ctr == nullptr) break;
            const unsigned pcur = (unsigned)__builtin_amdgcn_readfirstlane((int)vnext); if (pcur >= (unsigned)npool) break;
            row = poolbase + 2 * (int)pcur; rowb = row + 1; two = true;
            if (lane == 0) vnext = __hip_atomic_fetch_add(ctr, 1u, __ATOMIC_RELAXED, __HIP_MEMORY_SCOPE_AGENT);
        }
        u32x4 hw[2][4]; f32x4 xv[2][8];
        if (xsrc) {
#pragma unroll
            for (int q = 0; q < 2; ++q) { const int rr = q ? rowb : row;
                const u32x4* hr = (const u32x4*)(hf + (size_t)rr * D) + lane; const f32x4* xr = (const f32x4*)(xsrc + (size_t)rr * D) + 2 * lane;
#pragma unroll
                for (int c = 0; c < 4; ++c) { hw[q][c] = hr[64 * c]; xv[q][2 * c] = xr[128 * c]; xv[q][2 * c + 1] = xr[128 * c + 1]; } }
        } else {
            u32x4 hiw[2][4]; float rsp[2];
#pragma unroll
            for (int q = 0; q < 2; ++q) { const int rr = q ? rowb : row;
                const u32x4* hr = (const u32x4*)(hf + (size_t)rr * D) + lane; const u32x4* ar = (const u32x4*)(HI + (size_t)rr * D) + lane;
                rsp[q] = RS[rr];
#pragma unroll
                for (int c = 0; c < 4; ++c) { hw[q][c] = hr[64 * c]; hiw[q][c] = ar[64 * c]; } }
            const f32x4* gv4 = (const f32x4*)gprev + 2 * lane;
#pragma unroll
            for (int c = 0; c < 4; ++c) { const f32x4 ig0 = rcp4(gv4[128 * c]), ig1 = rcp4(gv4[128 * c + 1]);
#pragma unroll
                for (int q = 0; q < 2; ++q) { const float inv = __builtin_amdgcn_rcpf(rsp[q]);
                    xv[q][2 * c] = bf4lo(hiw[q][c]) * ig0 * inv; xv[q][2 * c + 1] = bf4hi(hiw[q][c]) * ig1 * inv; } }
        }
#pragma unroll
        for (int q = 0; q < 2; ++q) { if (q == 1 && !two) break; const int rr = q ? rowb : row;
            float ss = 0.f;
#pragma unroll
            for (int c = 0; c < 4; ++c) ss += dot4(bf4lo(hw[q][c])) + dot4(bf4hi(hw[q][c]));
            const float rs = rsqrtf(wave_sum(ss) * (1.f / D) + EPS) * w; float ss2 = 0.f;
            const f32x4* gp4 = (const f32x4*)gpost + 2 * lane;
#pragma unroll
            for (int c = 0; c < 4; ++c) { xv[q][2 * c] = xv[q][2 * c] + bf4lo(hw[q][c]) * rs * gp4[128 * c]; xv[q][2 * c + 1] = xv[q][2 * c + 1] + bf4hi(hw[q][c]) * rs * gp4[128 * c + 1];
                ss2 += dot4(xv[q][2 * c]) + dot4(xv[q][2 * c + 1]); }
            if (xdst) {
                f32x4* xo = (f32x4*)(xdst + (size_t)rr * D) + 2 * lane;
#pragma unroll
                for (int c = 0; c < 4; ++c) { xo[128 * c] = xv[q][2 * c]; xo[128 * c + 1] = xv[q][2 * c + 1]; }
            } else {
                const float rs2 = rsqrtf(wave_sum(ss2) * (1.f / D) + EPS);
                const f32x4* gn4 = (const f32x4*)gpre + 2 * lane; u32x4* oh = (u32x4*)(HI + (size_t)rr * D) + lane;
#pragma unroll
                for (int c = 0; c < 4; ++c) { const f32x4 y0 = xv[q][2 * c] * rs2 * gn4[128 * c], y1 = xv[q][2 * c + 1] * rs2 * gn4[128 * c + 1];
                    oh[64 * c] = (u32x4){pk2(y0.x, y0.y), pk2(y0.z, y0.w), pk2(y1.x, y1.y), pk2(y1.z, y1.w)}; }
                if (lane == 0) RS[rr] = rs2;
            }
        }
    }
}

constexpr int KS_STRIDE = 272, VT_STRIDE = 528, VT_OFF = 256 * KS_STRIDE;
static_assert(VT_OFF + 128 * VT_STRIDE <= LDS_BYTES, "attention LDS");
#define MFMA16(a, b, c) __builtin_amdgcn_mfma_f32_16x16x32_bf16((a), (b), (c), 0, 0, 0)
__device__ __forceinline__ void attn_phase(LAS unsigned char* lds, bf16_t* Z, bf16_t* OB12, float* LSE, int it0, int itstride, int nit, int tid) {
    const int wid = __builtin_amdgcn_readfirstlane(tid >> 6), lane = tid & 63, l15 = lane & 15, quad = lane >> 4;
    for (int ki = 0, it = it0; ki < nit && it < 768; ++ki, it += itstride) {
        const int sub = it & 15, br = (it >> 4) % 3, bg = it / 48, g = bg & 1, b = bg >> 1;
        int d, n, e; if (br == 0) { d = 1; n = sub; e = 0; } else if (br == 1) { d = 4; n = sub >> 2; e = sub & 3; } else { d = 16; n = 0; e = sub; }
        __syncthreads();
        {
            const int kp = tid >> 2, qtr = tid & 3, kj0 = 2 * kp;
            const bool valid = (n > 0) || (kj0 >= 128);
            u32x4 k0[4], k1[4], v0[4], v1[4];
            if (valid) {
                const int p0 = ((n - 1) * 128 + kj0) * d + e;
                const bf16_t* r0 = Z + (size_t)(b * SEQ + p0) * ZP + g * 128 + qtr * 32; const bf16_t* r1 = r0 + (size_t)d * ZP;
#pragma unroll
                for (int i = 0; i < 4; ++i) { k0[i] = *(const u32x4*)(r0 + 1024 + 8 * i); k1[i] = *(const u32x4*)(r1 + 1024 + 8 * i); v0[i] = *(const u32x4*)(r0 + 1280 + 8 * i); v1[i] = *(const u32x4*)(r1 + 1280 + 8 * i); }
            } else {
#pragma unroll
                for (int i = 0; i < 4; ++i) { k0[i] = (u32x4){0u, 0u, 0u, 0u}; k1[i] = k0[i]; v0[i] = k0[i]; v1[i] = k0[i]; }
            }
#pragma unroll
            for (int i = 0; i < 4; ++i) {
                *(LAS u32x4*)(lds + kj0 * KS_STRIDE + (qtr * 32 + 8 * i) * 2) = k0[i];
                *(LAS u32x4*)(lds + (kj0 + 1) * KS_STRIDE + (qtr * 32 + 8 * i) * 2) = k1[i];
#pragma unroll
                for (int w = 0; w < 4; ++w) { const unsigned a = v0[i][w], c = v1[i][w]; const int hd = qtr * 32 + 8 * i + 2 * w;
                    *(LAS unsigned*)(lds + VT_OFF + hd * VT_STRIDE + kj0 * 2) = (a & 0xffffu) | (c << 16);
                    *(LAS unsigned*)(lds + VT_OFF + (hd + 1) * VT_STRIDE + kj0 * 2) = (a >> 16) | (c & 0xffff0000u); }
            }
        }
        __syncthreads();
#pragma unroll 1
        for (int pass = 0; pass < 2; ++pass) {
            const int task = wid + 8 * pass, r = task & 3, c = task >> 2, head = g * 4 + r;
            const int kt0 = (n == 0) ? (8 - 2 * c) : 0;
            bf16x8 qf[2][4];
#pragma unroll
            for (int qt = 0; qt < 2; ++qt) { const int i = 32 * c + 16 * qt + l15; const size_t tok = (size_t)b * SEQ + (size_t)((n * 128 + i) * d + e);
                const bf16_t* qr = Z + tok * ZP + head * 128 + quad * 8;
#pragma unroll
                for (int ks = 0; ks < 4; ++ks) qf[qt][ks] = *(const bf16x8*)(qr + ks * 32); }
            f32x4 sacc[10][2];
#pragma unroll
            for (int kt = 0; kt < 10; ++kt) { sacc[kt][0] = (f32x4){0.f, 0.f, 0.f, 0.f}; sacc[kt][1] = sacc[kt][0]; }
#pragma unroll
            for (int kt = 0; kt < 10; ++kt) if (kt >= kt0) {
#pragma unroll
                for (int ks = 0; ks < 4; ++ks) { const bf16x8 kf = *(const LAS bf16x8*)(lds + (32 * c + 16 * kt + l15) * KS_STRIDE + (ks * 32 + quad * 8) * 2);
                    if (kt != 9) sacc[kt][0] = MFMA16(kf, qf[0][ks], sacc[kt][0]);
                    if (kt != 0) sacc[kt][1] = MFMA16(kf, qf[1][ks], sacc[kt][1]); }
            }
            const float SC = 0.08838834764831845f * 1.4426950408889634f;
            float mrow[2], lrow[2];
#pragma unroll
            for (int qt = 0; qt < 2; ++qt) { float mx = -__builtin_inff();
#pragma unroll
                for (int kt = 0; kt < 10; ++kt) { const int dd = kt - qt; const bool dead = (kt < kt0);
#pragma unroll
                    for (int j = 0; j < 4; ++j) { float s;
                        if (dd >= 1 && dd <= 7) s = sacc[kt][qt][j] * SC;
                        else if (dd == 0) s = (4 * quad + j >= l15) ? sacc[kt][qt][j] * SC : -__builtin_inff();
                        else if (dd == 8) s = (4 * quad + j <= l15) ? sacc[kt][qt][j] * SC : -__builtin_inff();
                        else s = -__builtin_inff();
                        if (dead) s = -__builtin_inff();
                        sacc[kt][qt][j] = s; mx = fmaxf(mx, s); } }
                mx = fmaxf(mx, __shfl_xor(mx, 16)); mx = fmaxf(mx, __shfl_xor(mx, 32));
                float l = 0.f;
#pragma unroll
                for (int kt = 0; kt < 10; ++kt) { const int dd = kt - qt;
#pragma unroll
                    for (int j = 0; j < 4; ++j) { const float pv = (dd < 0 || dd > 8) ? 0.f : __builtin_amdgcn_exp2f(sacc[kt][qt][j] - mx); sacc[kt][qt][j] = pv; l += pv; } }
                l += __shfl_xor(l, 16); l += __shfl_xor(l, 32);
                mrow[qt] = mx; lrow[qt] = l; }
            bf16x8 pf[5][2];
#pragma unroll
            for (int kp = 0; kp < 5; ++kp)
#pragma unroll
                for (int qt = 0; qt < 2; ++qt) { const f32x4 a = sacc[2 * kp][qt], c2 = sacc[2 * kp + 1][qt];
                    const u32x4 w = (u32x4){pk2(a[0], a[1]), pk2(a[2], a[3]), pk2(c2[0], c2[1]), pk2(c2[2], c2[3])}; pf[kp][qt] = __builtin_bit_cast(bf16x8, w); }
            f32x4 oacc[8][2];
#pragma unroll
            for (int ht = 0; ht < 8; ++ht) { oacc[ht][0] = (f32x4){0.f, 0.f, 0.f, 0.f}; oacc[ht][1] = oacc[ht][0]; }
#pragma unroll
            for (int kp = 0; kp < 5; ++kp) if (2 * kp >= kt0) {
#pragma unroll
                for (int ht = 0; ht < 8; ++ht) { const LAS unsigned char* vp = lds + VT_OFF + (16 * ht + l15) * VT_STRIDE + (32 * c + 32 * kp + 4 * quad) * 2;
                    const u32x2 lo = *(const LAS u32x2*)vp, hi = *(const LAS u32x2*)(vp + 32);
                    const bf16x8 vf = __builtin_bit_cast(bf16x8, ((u32x4){lo.x, lo.y, hi.x, hi.y}));
                    oacc[ht][0] = MFMA16(vf, pf[kp][0], oacc[ht][0]); oacc[ht][1] = MFMA16(vf, pf[kp][1], oacc[ht][1]); }
            }
#pragma unroll
            for (int qt = 0; qt < 2; ++qt) { const int i = 32 * c + 16 * qt + l15; const size_t tok = (size_t)b * SEQ + (size_t)((n * 128 + i) * d + e);
                const float inv = 1.0f / lrow[qt];
                bf16_t* op = (br == 0 ? Z + tok * ZP + NIN : OB12 + (size_t)b * SEQ * D + (size_t)(br - 1) * SEQ * QD + (tok - (size_t)b * SEQ) * QD) + head * 128 + 4 * quad;
#pragma unroll
                for (int ht = 0; ht < 8; ++ht) { const f32x4 o = oacc[ht][qt] * inv; *(u32x2*)(op + 16 * ht) = (u32x2){pk2(o.x, o.y), pk2(o.z, o.w)}; }
                if (quad == 0) LSE[((size_t)br * T + tok) * 8 + head] = mrow[qt] * 0.6931471805599453f + __logf(lrow[qt]); }
        }
    }
}

__device__ __forceinline__ void combine_phase(const bf16_t* Z, const bf16_t* OB12, const float* LSE, const float* convw, const float* ga, const float* gc, bf16_t* XN, int boff, int row0, int rstride, int nrows, int lane) {
    for (int kr = 0, t = row0; kr < nrows && t < T; ++kr, t += rstride) {
        const int s = t & (SEQ - 1);
        float av[2][8], cv[2][8]; float ssa = 0.f, ssc = 0.f;
#pragma unroll
        for (int j = 0; j < 2; ++j) { const int chunk = lane + 64 * j, col = chunk * 8, head = chunk >> 4;
            const float l0 = LSE[((size_t)0 * T + t) * 8 + head], l1 = LSE[((size_t)1 * T + t) * 8 + head], l2 = LSE[((size_t)2 * T + t) * 8 + head];
            const float mx = fmaxf(l0, fmaxf(l1, l2)); float w0 = __expf(l0 - mx), w1 = __expf(l1 - mx), w2 = __expf(l2 - mx); const float inv = 1.0f / (w0 + w1 + w2); w0 *= inv; w1 *= inv; w2 *= inv;
            const u32x4 o0 = *(const u32x4*)(Z + (size_t)t * ZP + NIN + col), o1 = *(const u32x4*)(OB12 + (size_t)(t >> 11) * SEQ * D + (size_t)s * QD + col), o2 = *(const u32x4*)(OB12 + (size_t)(t >> 11) * SEQ * D + (size_t)SEQ * QD + (size_t)s * QD + col);
#pragma unroll
            for (int w = 0; w < 4; ++w) { const float a0 = w0 * bflo(o0[w]) + w1 * bflo(o1[w]) + w2 * bflo(o2[w]), a1 = w0 * bfhi(o0[w]) + w1 * bfhi(o1[w]) + w2 * bfhi(o2[w]);
                av[j][2 * w] = a0; av[j][2 * w + 1] = a1; ssa += a0 * a0 + a1 * a1; } }
#pragma unroll
        for (int j = 0; j < 2; ++j) { const int ch = (lane + 64 * j) * 8; const bf16_t* zr = Z + (size_t)t * ZP;
            const u32x4 hc0 = *(const u32x4*)(zr + 1536 + ch), bg0 = *(const u32x4*)(zr + 2560 + ch), cg0 = *(const u32x4*)(zr + 3584 + ch);
            u32x4 hc1 = (u32x4){0u, 0u, 0u, 0u}, cg1 = hc1, hc2 = hc1, cg2 = hc1;
            if (s >= 1) { hc1 = *(const u32x4*)(zr - ZP + 1536 + ch); cg1 = *(const u32x4*)(zr - ZP + 3584 + ch); }
            if (s >= 2) { hc2 = *(const u32x4*)(zr - 2 * ZP + 1536 + ch); cg2 = *(const u32x4*)(zr - 2 * ZP + 3584 + ch); }
            float wk[3][8];
#pragma unroll
            for (int k = 0; k < 3; ++k) { const f32x4 a = *(const f32x4*)(convw + k * QD + ch), b2 = *(const f32x4*)(convw + k * QD + ch + 4);
                wk[k][0] = a.x; wk[k][1] = a.y; wk[k][2] = a.z; wk[k][3] = a.w; wk[k][4] = b2.x; wk[k][5] = b2.y; wk[k][6] = b2.z; wk[k][7] = b2.w; }
#pragma unroll
            for (int w = 0; w < 4; ++w) {
                const float y0 = wk[2][2 * w] * (bflo(cg0[w]) * bflo(hc0[w])) + wk[1][2 * w] * (bflo(cg1[w]) * bflo(hc1[w])) + wk[0][2 * w] * (bflo(cg2[w]) * bflo(hc2[w]));
                const float y1 = wk[2][2 * w + 1] * (bfhi(cg0[w]) * bfhi(hc0[w])) + wk[1][2 * w + 1] * (bfhi(cg1[w]) * bfhi(hc1[w])) + wk[0][2 * w + 1] * (bfhi(cg2[w]) * bfhi(hc2[w]));
                const float c0 = bflo(bg0[w]) * y0, c1 = bfhi(bg0[w]) * y1; cv[j][2 * w] = c0; cv[j][2 * w + 1] = c1; ssc += c0 * c0 + c1 * c1; } }
        const float ra = rsqrtf(wave_sum(ssa) * (1.f / QD) + EPS), rc = rsqrtf(wave_sum(ssc) * (1.f / QD) + EPS);
#pragma unroll
        for (int j = 0; j < 2; ++j) { const int col = (lane + 64 * j) * 8;
            const f32x4 g0 = *(const f32x4*)(ga + col), g1 = *(const f32x4*)(ga + col + 4), h0 = *(const f32x4*)(gc + col), h1 = *(const f32x4*)(gc + col + 4);
            u32x4 oa, oc;
            oa.x = pk2(av[j][0] * ra * g0.x, av[j][1] * ra * g0.y); oa.y = pk2(av[j][2] * ra * g0.z, av[j][3] * ra * g0.w); oa.z = pk2(av[j][4] * ra * g1.x, av[j][5] * ra * g1.y); oa.w = pk2(av[j][6] * ra * g1.z, av[j][7] * ra * g1.w);
            oc.x = pk2(cv[j][0] * rc * h0.x, cv[j][1] * rc * h0.y); oc.y = pk2(cv[j][2] * rc * h0.z, cv[j][3] * rc * h0.w); oc.z = pk2(cv[j][4] * rc * h1.x, cv[j][5] * rc * h1.y); oc.w = pk2(cv[j][6] * rc * h1.z, cv[j][7] * rc * h1.w);
            bf16_t* xo = XN + (size_t)t * D + (size_t)(t >> 11) * boff;
            *(u32x4*)(xo + col) = oa; *(u32x4*)(xo + QD + col) = oc; }
    }
}

#define XB_TMO      128
#define XB_XCNT(j)  (256  + 64 * (j))
#define XB_XSUB(j)  (1280 + 64 * (j))
#define XB_XGEN(j)  (2304 + 64 * (j))
#define XB_TOP      3328
#define XB_TOPGEN   3392
#define XCD_BAR_WORDS 3456
#define XB_SPIN_CAP (1u << 18)
__device__ __forceinline__ unsigned xb_ld(unsigned* p)              { return __hip_atomic_load(p, __ATOMIC_RELAXED, __HIP_MEMORY_SCOPE_AGENT); }
__device__ __forceinline__ unsigned xb_add(unsigned* p, unsigned v) { return __hip_atomic_fetch_add(p, v, __ATOMIC_RELAXED, __HIP_MEMORY_SCOPE_AGENT); }
__device__ __forceinline__ unsigned xb_xcc_id() { return (unsigned)__builtin_amdgcn_s_getreg((3 << 11) | 20) & 0xFu; }
#define XB_SPIN(cond, bar) do { unsigned _sp = 0; while (cond) { __builtin_amdgcn_s_sleep(1); \
    if ((++_sp & 255u) == 0u) { if (xb_ld(&(bar)[XB_TMO])) break; if (_sp > XB_SPIN_CAP) { atomicAdd(&(bar)[XB_TMO], 1u); break; } } } } while (0)
__device__ __forceinline__ void xcd_barrier_complete(unsigned* bar, unsigned x, unsigned& nloc, unsigned& nx) {
    const unsigned G = gridDim.x * gridDim.y * gridDim.z;
    unsigned sum, cnt, mine, sp = 0u;
    for (;;) {
        sum = 0u; cnt = 0u; mine = 0u;
#pragma unroll
        for (unsigned j = 0; j < 16; ++j) { const unsigned c = xb_ld(&bar[XB_XCNT(j)]); sum += c; cnt += (c > 0u) ? 1u : 0u; mine = (j == x) ? c : mine; }
        if (sum == G) break;
        __builtin_amdgcn_s_sleep(1);
        if ((++sp & 255u) == 0u) { if (xb_ld(&bar[XB_TMO])) break; if (sp > XB_SPIN_CAP) { atomicAdd(&bar[XB_TMO], 1u); break; } }
    }
    nloc = mine > 0u ? mine : 1u; nx = cnt > 0u ? cnt : 1u;
}
__device__ __forceinline__ void xcd_barrier(unsigned* bar, volatile LAS unsigned* st, int tid) {
    asm volatile("s_waitcnt vmcnt(0)" ::: "memory");
    __syncthreads();
    if (tid == 0) {
        const unsigned x = xb_xcc_id();
        __builtin_amdgcn_s_waitcnt(0);
        unsigned nloc = st[0], nx = st[1];
        if (nloc == 0u) { xcd_barrier_complete(bar, x, nloc, nx); st[0] = nloc; st[1] = nx; }
        const unsigned old = xb_add(&bar[XB_XSUB(x)], 1u);
        const unsigned gen = old / nloc;
        if (old + 1u == (gen + 1u) * nloc) {
            __builtin_amdgcn_fence(__ATOMIC_RELEASE, "agent");
            asm volatile("s_waitcnt vmcnt(0)" ::: "memory");
            const unsigned og = xb_add(&bar[XB_TOP], 1u);
            const unsigned tg = og / nx;
            if (og + 1u == (tg + 1u) * nx) xb_add(&bar[XB_TOPGEN], 1u);
            else XB_SPIN(xb_ld(&bar[XB_TOPGEN]) == tg, bar);
            __builtin_amdgcn_fence(__ATOMIC_ACQUIRE, "agent");
            xb_add(&bar[XB_XGEN(x)], 1u);
            asm volatile("s_waitcnt vmcnt(0)" ::: "memory");
        } else {
            XB_SPIN(xb_ld(&bar[XB_XGEN(x)]) == gen, bar);
            __builtin_amdgcn_fence(__ATOMIC_ACQUIRE, "agent");
            asm volatile("s_waitcnt vmcnt(0)" ::: "memory");
        }
    }
    __syncthreads();
}
#define XL_WORD(x) (4096 + 64 * (x))
__device__ __forceinline__ void xcc_local_barrier(unsigned* cnt, unsigned target, int tid) {
    asm volatile("s_waitcnt vmcnt(0)" ::: "memory");
    __syncthreads();
    if (tid == 0) {
        __builtin_amdgcn_s_waitcnt(0);
        (void)xb_add(cnt, 1u);
        unsigned sp = 0u;
        while (xb_ld(cnt) < target) { __builtin_amdgcn_s_sleep(1); if (++sp > (1u << 24)) break; }
        __builtin_amdgcn_fence(__ATOMIC_ACQUIRE, "agent");
        asm volatile("s_waitcnt vmcnt(0)" ::: "memory");
    }
    __syncthreads();
}
struct Ctx { int tid, lane, wave, G, bid, gw, ngw; };
__device__ __forceinline__ int make_tid(int wave_s) {
    int ln; asm volatile("v_mbcnt_lo_u32_b32 %0, -1, 0\n\tv_mbcnt_hi_u32_b32 %0, -1, %0" : "=&v"(ln));
    return wave_s * 64 + ln;
}
__device__ __forceinline__ Ctx make_ctx(int wave_s) {
    const int t = make_tid(wave_s);
    Ctx c; c.tid = t; c.lane = t & 63; c.wave = wave_s; c.G = gridDim.x; c.bid = blockIdx.x; c.gw = c.bid * NWAVES + c.wave; c.ngw = c.G * NWAVES; return c;
}
__device__ __forceinline__ const Params* get_params() {
    const Params* pp = (const Params*)__builtin_amdgcn_kernarg_segment_ptr(); asm volatile("" : "+s"(pp)); return pp;
}
__global__ void __launch_bounds__(NTHREADS) fwd_megakernel(Params p_unused) {
    extern __shared__ __attribute__((aligned(16))) unsigned char lds_raw[];
    LAS unsigned char* lds = (LAS unsigned char*)lds_raw;
    cg::grid_group grid = cg::this_grid();
    const int wave_s = __builtin_amdgcn_readfirstlane((int)threadIdx.x >> 6);
    volatile LAS unsigned* xst = (volatile LAS unsigned*)(lds + LDS_BYTES - 16);
    { unsigned* barp = (unsigned*)(get_params()->ws + WS_CTL); const unsigned xcc = xb_xcc_id();
      if (threadIdx.x == 0) { xst[0] = 0u; xst[1] = 0u; xst[2] = xb_add(&barp[XB_XCNT(xcc)], 1u); } }
    { const Params* pp = get_params(); const Ctx c = make_ctx(wave_s); prologue_phase(*pp, lds, c.gw, c.ngw, c.wave, c.lane); }
    __syncthreads();
    if (gridDim.y == 0x7fffu) grid.sync();
    xcd_barrier((unsigned*)(get_params()->ws + WS_CTL), xst, make_tid(wave_s));
    { unsigned* barp = (unsigned*)(get_params()->ws + WS_CTL);
      if (threadIdx.x == 0) { bool even = (gridDim.x == 256);
          for (unsigned j = 0; j < 16; ++j) { const unsigned cn = xb_ld(&barp[XB_XCNT(j)]); even = even && (j < 8 ? cn == 32u : cn == 0u); }
          xst[3] = even ? 1u : 0u; } }
    __syncthreads();
    const unsigned xcc_s = xb_xcc_id();
    const bool xlocal = __builtin_amdgcn_readfirstlane((int)xst[3]) != 0;
    const int vbid = xlocal ? (int)(__builtin_amdgcn_readfirstlane((int)xst[2]) * 8 + (int)xcc_s) : (int)blockIdx.x;
    const bool grouped = (gridDim.x == 256);
    const int vb_b = vbid & 7, vb_r = vbid >> 3;
    unsigned lk = 0u;
#define GRID_BAR() do { if (xlocal) { ++lk; xcc_local_barrier((unsigned*)(get_params()->ws + WS_CTL) + XL_WORD(xcc_s), 32u * lk, make_tid(wave_s)); } \
                        else xcd_barrier((unsigned*)(get_params()->ws + WS_CTL), xst, make_tid(wave_s)); } while (0)
#define ROW0(c) (grouped ? vb_b * SEQ + vb_r * 8 + (c).wave : (c).gw)
#define RSTRIDE(c) (grouped ? 256 : (c).ngw)
#define NROWS() (grouped ? 8 : T)
    unsigned nri = 0u;
#define DYN_WORD(i, b) (5120 + 16 * ((int)(i) * 8 + (b)))
#define NR_ARGS(c) ROW0(c), RSTRIDE(c), (grouped ? 6 : T), (grouped ? (unsigned*)(ws + WS_CTL) + DYN_WORD(nri, vb_b) : nullptr), vb_b * SEQ + 1536, 256, (c).lane
#pragma unroll 1
    for (int l = 0; l < DEPTH; ++l) {
#pragma unroll 1
        for (int f = 0; f < 2; ++f) {
            if (f == 1) {
                { const Params* pp = get_params(); unsigned char* ws = pp->ws; const int G = gridDim.x, bid = vbid;
                  pg8::Gemm g{(const bf16_t*)(ws + WS_XN), (const bf16_t*)(ws + WS_W + (size_t)l * SZ_LAYER + OFF_IN), T, NIN, D}; pg8::StaticOrder S; S.init(T, NIN, G, bid); pg8::EpiBf16 E{(bf16_t*)(ws + WS_BIG), ZP};
                  pg8::gemm_phase<pg8::EpiBf16, pg8::StaticOrder, true, true>(lds, g, S, E, make_tid(wave_s)); }
                GRID_BAR();
                { const Params* pp = get_params(); unsigned char* ws = pp->ws; const Ctx c = make_ctx(wave_s);
                  attn_phase(lds, (bf16_t*)(ws + WS_BIG), (bf16_t*)(ws + WS_HF + (size_t)T * D * 2), (float*)(ws + WS_LSE), grouped ? (vb_b * 2 + (vb_r & 1)) * 48 + (vb_r >> 1) : c.bid, grouped ? 16 : c.G, grouped ? 3 : 768, c.tid); }
                GRID_BAR();
                { const Params* pp = get_params(); unsigned char* ws = pp->ws; const Ctx c = make_ctx(wave_s);
                  combine_phase((const bf16_t*)(ws + WS_BIG), (const bf16_t*)(ws + WS_HF + (size_t)T * D * 2), (const float*)(ws + WS_LSE), pp->in[7] + (size_t)l * 3 * QD, pp->in[8] + (size_t)l * QD, pp->in[9] + (size_t)l * QD,
                                (bf16_t*)(ws + WS_HF), 0, ROW0(c), RSTRIDE(c), NROWS(), c.lane); }
                GRID_BAR();
                { const Params* pp = get_params(); unsigned char* ws = pp->ws; const int G = gridDim.x, bid = vbid;
                  pg8::Gemm g{(const bf16_t*)(ws + WS_HF), (const bf16_t*)(ws + WS_W + (size_t)l * SZ_LAYER + OFF_OUT), T, D, D}; pg8::StaticOrder S; S.init(T, D, G, bid); pg8::EpiBf16 E{(bf16_t*)(ws + WS_HF + (size_t)T * D * 2), D};
                  pg8::gemm_phase<pg8::EpiBf16, pg8::StaticOrder, true, true>(lds, g, S, E, make_tid(wave_s)); }
                GRID_BAR();
                { const Params* pp = get_params(); unsigned char* ws = pp->ws; const Ctx c = make_ctx(wave_s);
                  normres_phase((const bf16_t*)(ws + WS_HF + (size_t)T * D * 2), nullptr, pp->in[5] + (size_t)l * D, (bf16_t*)(ws + WS_XN), (bf16_t*)(ws + WS_LO), (float*)(ws + WS_RS), nullptr, pp->in[11] + (size_t)l * D, 1.0f, pp->in[12] + (size_t)l * D, NR_ARGS(c)); ++nri; }
                GRID_BAR();
            }
            { const Params* pp = get_params(); unsigned char* ws = pp->ws; const int G = gridDim.x, bid = vbid;
              pg8::Gemm g{(const bf16_t*)(ws + WS_XN), (const bf16_t*)(ws + WS_W + (size_t)l * SZ_LAYER + (f ? OFF_GU2 : OFF_GU1)), T, NGU, D}; pg8::StaticOrder S; S.init(T, NGU, G, bid); pg8::EpiSwiGLU E{(bf16_t*)(ws + WS_BIG), FF};
              pg8::gemm_phase<pg8::EpiSwiGLU, pg8::StaticOrder, true, true>(lds, g, S, E, make_tid(wave_s)); }
            GRID_BAR();
            { const Params* pp = get_params(); unsigned char* ws = pp->ws; const int G = gridDim.x, bid = vbid;
              pg8::Gemm g{(const bf16_t*)(ws + WS_BIG), (const bf16_t*)(ws + WS_W + (size_t)l * SZ_LAYER + (f ? OFF_D2 : OFF_D1)), T, D, FF}; pg8::StaticOrder S; S.init(T, D, G, bid); pg8::EpiBf16 E{(bf16_t*)(ws + WS_HF), D};
              pg8::gemm_phase<pg8::EpiBf16, pg8::StaticOrder, true, true>(lds, g, S, E, make_tid(wave_s)); }
            GRID_BAR();
            { const Params* pp = get_params(); unsigned char* ws = pp->ws; const Ctx c = make_ctx(wave_s);
              const float* gpost = (f ? pp->in[15] : pp->in[4]) + (size_t)l * D;
              const float* gpre = f ? (l + 1 < DEPTH ? pp->in[1] + (size_t)(l + 1) * D : nullptr) : pp->in[5] + (size_t)l * D;
              const float* gprev = (f ? pp->in[12] : pp->in[1]) + (size_t)l * D;
              const float* xsrc = (l == 0 && f == 0) ? pp->in[0] : nullptr;
              float* xdst = (l == DEPTH - 1 && f == 1) ? pp->out : nullptr;
              normres_phase((const bf16_t*)(ws + WS_HF), xsrc, gprev, (bf16_t*)(ws + WS_XN), (bf16_t*)(ws + WS_LO), (float*)(ws + WS_RS), xdst, gpost, 0.5f, gpre, NR_ARGS(c)); ++nri; }
            if (!(l == DEPTH - 1 && f == 1)) GRID_BAR();
        }
    }
}

extern "C" void kernel_launch(void* const* d_in, const int* in_sizes, int n_in, void* d_out, int out_size, void* d_ws, size_t ws_size, hipStream_t stream) {
    static int grid_blocks = 0;
    if (grid_blocks == 0) {
        if (n_in != 16 || out_size != T * D || ws_size < WS_END) { fprintf(stderr, "kernel_launch: unexpected shapes (n_in %d out %d ws %zu need %zu)\n", n_in, out_size, ws_size, (size_t)WS_END); grid_blocks = -1; return; }
        int dev = 0, cus = 0, per_cu = 0;
        hipGetDevice(&dev);
        hipDeviceGetAttribute(&cus, hipDeviceAttributeMultiprocessorCount, dev);
        if (hipFuncSetAttribute((const void*)fwd_megakernel, hipFuncAttributeMaxDynamicSharedMemorySize, LDS_BYTES) != hipSuccess) { fprintf(stderr, "kernel_launch: hipFuncSetAttribute failed\n"); }
        if (hipOccupancyMaxActiveBlocksPerMultiprocessor(&per_cu, (const void*)fwd_megakernel, NTHREADS, LDS_BYTES) != hipSuccess || per_cu < 1) { fprintf(stderr, "kernel_launch: occupancy query gave %d\n", per_cu); per_cu = 1; }
        (void)hipGetLastError();
        grid_blocks = cus * 1;
        if (grid_blocks <= 0) grid_blocks = 256;
    }
    if (grid_blocks < 0) return;
    Params p{};
    for (int i = 0; i < 16; ++i) p.in[i] = (const float*)d_in[i];
    p.out = (float*)d_out; p.ws = (unsigned char*)d_ws;
    if (hipMemsetAsync((unsigned char*)d_ws + WS_CTL, 0, 32768, stream) != hipSuccess) fprintf(stderr, "kernel_launch: memset of barrier words failed\n");
    void* args[] = {&p};
    hipError_t e = hipLaunchCooperativeKernel((const void*)fwd_megakernel, dim3(grid_blocks), dim3(NTHREADS), args, LDS_BYTES, stream);
    if (e != hipSuccess) fprintf(stderr, "cooperative launch failed: %s (grid %d)\n", hipGetErrorString(e), grid_blocks);
}
```

```cpp
#include <hip/hip_runtime.h>
#include <hip/hip_cooperative_groups.h>
#include <cstdio>
#include <cstdint>
namespace pg8 {
#define PG8_LAS __attribute__((address_space(3)))
typedef unsigned short bf16_t;
typedef short bf16x8 __attribute__((ext_vector_type(8)));
typedef float f32x4 __attribute__((ext_vector_type(4)));
typedef unsigned u32x4 __attribute__((ext_vector_type(4)));
constexpr int BM = 256, BK = 64, HALF = 128, HTB = HALF * BK * 2  , STAGE_BYTES = 8 * HTB, NXCD = 8, WGM = 8;

__host__ __device__ __forceinline__ int lds_byte(int r, int c) { const int st = (r >> 4) * 2 + (c >> 5), rr = r & 15, cc = c & 31, ob = rr * 64 + cc * 2; return st * 1024 + (ob ^ (((ob >> 9) & 1) << 5)); }
__host__ __device__ __forceinline__ void stage_rc(int b, int& R, int& C) { const int st = b / 1024, sb = b % 1024, swz = sb ^ (((sb >> 9) & 1) << 5); R = (st >> 1) * 16 + swz / 64; C = (st & 1) * 32 + (swz % 64) / 2; }
__host__ __device__ __forceinline__ int perm32(int rho) { const int n = rho >> 4, i = rho & 15; return 8 * (i >> 2) + 4 * n + (i & 3); }

struct Unit { int pm, pn; };
struct Gemm { const bf16_t* A; const bf16_t* Bt; int M, N, K; };

struct StaticOrder {
    int nM, nN, nwg, G, c;
    __host__ __device__ void init(int M, int N, int G_, int c_) { nM = M / BM; nN = N / BM; nwg = nM * nN; G = G_; c = c_; }
    __host__ __device__ bool next(int i, Unit& u) const {
        const long L = (long)i * G + c; if (L >= nwg) return false;
        int wgid = (int)L; { const int q = nwg / NXCD, r = nwg % NXCD, xcd = wgid % NXCD, off = wgid / NXCD; wgid = (xcd < r ? xcd * (q + 1) : r * (q + 1) + (xcd - r) * q) + off; }
        const int nig = WGM * nN, gid = wgid / nig, fm = gid * WGM, gsz = (nM - fm) < WGM ? (nM - fm) : WGM;
        u.pm = fm + ((wgid % nig) % gsz); u.pn = (wgid % nig) / gsz; return true;
    }
    __device__ __forceinline__ void a_ready(const Unit&) const {}
    __device__ __forceinline__ void done(const Unit&) const {}
};
__device__ __forceinline__ unsigned cvt_pk_bf16(float lo, float hi) { unsigned r; asm volatile("v_cvt_pk_bf16_f32 %0, %1, %2" : "=v"(r) : "v"(lo), "v"(hi)); return r; }
struct EpiF32 {
    static constexpr bool PERM = false, AFTER_DRAIN = false;
    float* C; int ldc;
    __device__ __forceinline__ void operator()(const f32x4 (&acc)[2][2][4][2], const Unit& u, int wr, int wc, int fr, int fq) const {
        const int row0 = u.pm * BM + wr * 64 + fr, col0 = u.pn * BM + wc * 32 + 4 * fq;
#pragma unroll
        for (int ai = 0; ai < 2; ++ai)
#pragma unroll
            for (int m = 0; m < 4; ++m) { float* rowp = C + (size_t)(row0 + ai * HALF + m * 16) * ldc + col0;
#pragma unroll
                for (int bj = 0; bj < 2; ++bj)
#pragma unroll
                    for (int n = 0; n < 2; ++n) *(f32x4*)(rowp + bj * HALF + n * 16) = acc[ai][bj][m][n]; }
    }
};
struct EpiBf16 {
    static constexpr bool PERM = true, AFTER_DRAIN = false;
    bf16_t* O; int ldc;
    __device__ __forceinline__ void operator()(const f32x4 (&acc)[2][2][4][2], const Unit& u, int wr, int wc, int fr, int fq) const {
        const int row0 = u.pm * BM + wr * 64 + fr, col0 = u.pn * BM + wc * 32 + 8 * fq;
#pragma unroll
        for (int ai = 0; ai < 2; ++ai)
#pragma unroll
            for (int m = 0; m < 4; ++m) { bf16_t* rowp = O + (size_t)(row0 + ai * HALF + m * 16) * ldc + col0;
#pragma unroll
                for (int bj = 0; bj < 2; ++bj) { const f32x4 v0 = acc[ai][bj][m][0], v1 = acc[ai][bj][m][1];
                    u32x4 w; w.x = cvt_pk_bf16(v0[0], v0[1]); w.y = cvt_pk_bf16(v0[2], v0[3]); w.z = cvt_pk_bf16(v1[0], v1[1]); w.w = cvt_pk_bf16(v1[2], v1[3]);
                    *(u32x4*)(rowp + bj * HALF) = w; } }
    }
};
__device__ __forceinline__ float silu_mul(float g, float u) { return g * u * __builtin_amdgcn_rcpf(1.0f + __builtin_amdgcn_exp2f(g * -1.4426950408889634f)); }
struct EpiSwiGLU {
    static constexpr bool PERM = true, AFTER_DRAIN = false;
    bf16_t* O; int ldc;
    __device__ __forceinline__ void operator()(const f32x4 (&acc)[2][2][4][2], const Unit& u, int wr, int wc, int fr, int fq) const {
        const int row0 = u.pm * BM + wr * 64 + fr, col0 = u.pn * HALF + wc * 32 + 8 * fq;
#pragma unroll
        for (int ai = 0; ai < 2; ++ai)
#pragma unroll
            for (int m = 0; m < 4; ++m) { bf16_t* rowp = O + (size_t)(row0 + ai * HALF + m * 16) * ldc + col0;
                const f32x4 g0 = acc[ai][0][m][0], g1 = acc[ai][0][m][1], u0 = acc[ai][1][m][0], u1 = acc[ai][1][m][1];
                u32x4 w; w.x = cvt_pk_bf16(silu_mul(g0[0], u0[0]), silu_mul(g0[1], u0[1])); w.y = cvt_pk_bf16(silu_mul(g0[2], u0[2]), silu_mul(g0[3], u0[3]));
                w.z = cvt_pk_bf16(silu_mul(g1[0], u1[0]), silu_mul(g1[1], u1[1])); w.w = cvt_pk_bf16(silu_mul(g1[2], u1[2]), silu_mul(g1[3], u1[3]));
                *(u32x4*)rowp = w; }
    }
};

template <class Epi, class Sched, bool ALIGN_EPI = false, bool SP2 = false>
__device__ __forceinline__ void gemm_phase(PG8_LAS unsigned char* lds, const Gemm g, const Sched& S, const Epi& E, int tid_in) {
    int tid_l = tid_in; asm volatile("" : "+v"(tid_l));
    const int tid = tid_l, wid = __builtin_amdgcn_readfirstlane(tid >> 6), lane = tid & 63, wr = wid >> 2, wc = wid & 3, fr = lane & 15, fq = lane >> 4;
    const int K = g.K, nt = K / BK;
    unsigned voffA[2], voffB[2];
#pragma unroll
    for (int i = 0; i < 2; ++i) { int R, C; stage_rc(tid * 16 + i * 8192, R, C); const int Rb = Epi::PERM ? ((R & ~31) + perm32(R & 31)) : R;
        voffA[i] = (unsigned)(R * K + C) * 2u; voffB[i] = (unsigned)(Rb * K + C) * 2u; }
    const size_t kstep = (size_t)(BK * 2);
    const size_t hstep = (size_t)HALF * K * 2;
    const size_t tstep = 2 * hstep;
    const unsigned ldsw = (unsigned)wid * 1024u;
    const int aoff = lds_byte(wr * 64 + fr, fq * 8), boff = lds_byte(wc * 32 + fr, fq * 8);
#define PG8_SA(b, h) (((b) * 2 + (h)) * HTB)
#define PG8_SB(b, h) ((4 + (b) * 2 + (h)) * HTB)
#define PG8_STAGE(bufoff, gbase, voff) do { _Pragma("unroll") for (int _i = 0; _i < 2; ++_i) \
        __builtin_amdgcn_global_load_lds((const unsigned*)((const char*)(gbase) + (voff)[_i]), (PG8_LAS unsigned*)(lds + (bufoff) + ldsw + _i * 8192), 16, 0, 0); } while (0)
#define PG8_LDA(dst, b, h) do { _Pragma("unroll") for (int m = 0; m < 4; ++m) _Pragma("unroll") for (int k = 0; k < 2; ++k) dst[m][k] = *(const PG8_LAS bf16x8*)(lds + PG8_SA(b, h) + aoff + m * 2048 + k * 1024); } while (0)
#define PG8_LDB(dst, b, h) do { _Pragma("unroll") for (int n = 0; n < 2; ++n) _Pragma("unroll") for (int k = 0; k < 2; ++k) dst[n][k] = *(const PG8_LAS bf16x8*)(lds + PG8_SB(b, h) + boff + n * 2048 + k * 1024); } while (0)
#define PG8_MMA(ai, bj, At, Bt) do { __builtin_amdgcn_s_setprio(1); _Pragma("unroll") for (int m = 0; m < 4; ++m) _Pragma("unroll") for (int n = 0; n < 2; ++n) _Pragma("unroll") for (int k = 0; k < 2; ++k) \
        acc[ai][bj][m][n] = __builtin_amdgcn_mfma_f32_16x16x32_bf16(Bt[n][k], At[m][k], acc[ai][bj][m][n], 0, 0, 0); __builtin_amdgcn_s_setprio(0); } while (0)
#define PG8_WAIT_V(n) asm volatile("s_waitcnt vmcnt(" #n ")" ::: "memory")
#define PG8_WAIT_L(n) asm volatile("s_waitcnt lgkmcnt(" #n ")" ::: "memory")
#define PG8_BAR __builtin_amdgcn_s_barrier()
#define PG8_SCHED __builtin_amdgcn_sched_barrier(0)
    Unit cur, nxt; int ui = 0;
    if (!S.next(0, cur)) return;
    f32x4 acc[2][2][4][2];
#pragma unroll
    for (int a = 0; a < 2; ++a)
#pragma unroll
        for (int b = 0; b < 2; ++b)
#pragma unroll
            for (int m = 0; m < 4; ++m)
#pragma unroll
                for (int n = 0; n < 2; ++n) acc[a][b][m][n] = (f32x4){0.f, 0.f, 0.f, 0.f};
    bf16x8 At[4][2], B0[2][2], B1[2][2];
    const char* cA = (const char*)g.A + (size_t)cur.pm * tstep; const char* cB = (const char*)g.Bt + (size_t)cur.pn * tstep;
    S.a_ready(cur);
    if constexpr (SP2) {
        PG8_STAGE(PG8_SB(0, 0), cB, voffB); PG8_STAGE(PG8_SB(0, 1), cB + hstep, voffB); PG8_STAGE(PG8_SA(0, 0), cA, voffA); PG8_STAGE(PG8_SA(0, 1), cA + hstep, voffA);
        if (wr == 1) PG8_BAR;
        PG8_WAIT_V(2); PG8_BAR;
        PG8_STAGE(PG8_SB(1, 0), cB + kstep, voffB); PG8_STAGE(PG8_SA(1, 0), cA + kstep, voffA); PG8_STAGE(PG8_SB(1, 1), cB + hstep + kstep, voffB);
        PG8_WAIT_V(6); PG8_BAR;
    } else {
        PG8_STAGE(PG8_SB(0, 0), cB, voffB); PG8_STAGE(PG8_SA(0, 0), cA, voffA); PG8_STAGE(PG8_SB(0, 1), cB + hstep, voffB); PG8_STAGE(PG8_SA(0, 1), cA + hstep, voffA);
        if (wr == 1) PG8_BAR;
        PG8_WAIT_V(4); PG8_BAR;
        PG8_STAGE(PG8_SB(1, 0), cB + kstep, voffB); PG8_STAGE(PG8_SA(1, 0), cA + kstep, voffA); PG8_STAGE(PG8_SB(1, 1), cB + hstep + kstep, voffB);
        PG8_WAIT_V(6); PG8_BAR;
    }
    for (;;) {
        const bool has_next = S.next(ui + 1, nxt);
        const char* nA = has_next ? (const char*)g.A + (size_t)nxt.pm * tstep : cA; const char* nB = has_next ? (const char*)g.Bt + (size_t)nxt.pn * tstep : cB;
        for (int t = 0; t < nt; t += 2) {
            const bool last = (t == nt - 2);
            const char* a1 = cA + (size_t)(t + 1) * kstep;
            const char* a2 = last ? nA : cA + (size_t)(t + 2) * kstep; const char* b2 = last ? nB : cB + (size_t)(t + 2) * kstep;
            const char* a3 = a2 + kstep; const char* b3 = b2 + kstep;
            if (last && has_next) S.a_ready(nxt);
            if constexpr (SP2) {
            PG8_LDB(B0, 0, 0); PG8_LDB(B1, 0, 1); PG8_SCHED; PG8_LDA(At, 0, 0); PG8_STAGE(PG8_SA(1, 1), a1 + hstep, voffA);
            PG8_WAIT_V(8); PG8_WAIT_L(0); PG8_BAR; PG8_MMA(0, 0, At, B0); PG8_MMA(0, 1, At, B1); PG8_BAR; PG8_SCHED;
            PG8_LDA(At, 0, 1); PG8_STAGE(PG8_SB(0, 0), b2, voffB); PG8_STAGE(PG8_SB(0, 1), b2 + hstep, voffB); PG8_STAGE(PG8_SA(0, 0), a2, voffA);
            PG8_WAIT_V(8); PG8_WAIT_L(0); PG8_BAR; PG8_MMA(1, 0, At, B0); PG8_MMA(1, 1, At, B1); PG8_BAR; PG8_SCHED;
            PG8_LDB(B0, 1, 0); PG8_LDB(B1, 1, 1); PG8_SCHED; PG8_LDA(At, 1, 0); PG8_STAGE(PG8_SA(0, 1), a2 + hstep, voffA);
            PG8_WAIT_V(8); PG8_WAIT_L(0); PG8_BAR; PG8_MMA(0, 0, At, B0); PG8_MMA(0, 1, At, B1); PG8_BAR; PG8_SCHED;
            PG8_LDA(At, 1, 1); PG8_STAGE(PG8_SB(1, 0), b3, voffB); PG8_STAGE(PG8_SB(1, 1), b3 + hstep, voffB); PG8_STAGE(PG8_SA(1, 0), a3, voffA);
            PG8_WAIT_V(8); PG8_WAIT_L(0); PG8_BAR; PG8_MMA(1, 0, At, B0); PG8_MMA(1, 1, At, B1); PG8_BAR; PG8_SCHED;
            } else {
            PG8_LDB(B0, 0, 0); PG8_SCHED; PG8_LDA(At, 0, 0); PG8_STAGE(PG8_SA(1, 1), a1 + hstep, voffA);
            PG8_WAIT_L(8); PG8_BAR; PG8_WAIT_L(0); PG8_MMA(0, 0, At, B0); PG8_BAR; PG8_SCHED;
            PG8_LDB(B1, 0, 1); PG8_STAGE(PG8_SB(0, 0), b2, voffB);
            PG8_BAR; PG8_WAIT_L(0); PG8_MMA(0, 1, At, B1); PG8_BAR;
            PG8_LDA(At, 0, 1); PG8_STAGE(PG8_SA(0, 0), a2, voffA);
            PG8_BAR; PG8_WAIT_L(0); PG8_MMA(1, 0, At, B0); PG8_BAR; PG8_SCHED;
            PG8_STAGE(PG8_SB(0, 1), b2 + hstep, voffB);
            PG8_WAIT_V(6); PG8_BAR; PG8_MMA(1, 1, At, B1); PG8_BAR;
            PG8_LDB(B0, 1, 0); PG8_SCHED; PG8_LDA(At, 1, 0); PG8_STAGE(PG8_SA(0, 1), a2 + hstep, voffA);
            PG8_WAIT_L(8); PG8_BAR; PG8_WAIT_L(0); PG8_MMA(0, 0, At, B0); PG8_BAR; PG8_SCHED;
            PG8_LDB(B1, 1, 1); PG8_STAGE(PG8_SB(1, 0), b3, voffB);
            PG8_BAR; PG8_WAIT_L(0); PG8_MMA(0, 1, At, B1); PG8_BAR;
            PG8_LDA(At, 1, 1); PG8_STAGE(PG8_SA(1, 0), a3, voffA);
            PG8_BAR; PG8_WAIT_L(0); PG8_MMA(1, 0, At, B0); PG8_BAR; PG8_SCHED;
            PG8_STAGE(PG8_SB(1, 1), b3 + hstep, voffB);
            PG8_WAIT_V(6); PG8_BAR; PG8_MMA(1, 1, At, B1); PG8_BAR;
            }
        }
        if constexpr (ALIGN_EPI) { if (wr == 0) PG8_BAR; }
        if constexpr (!Epi::AFTER_DRAIN) { E(acc, cur, wr, wc, fr, fq); S.done(cur); }
        if (!has_next) break;
#pragma unroll
        for (int a = 0; a < 2; ++a)
#pragma unroll
            for (int b = 0; b < 2; ++b)
#pragma unroll
                for (int m = 0; m < 4; ++m)
#pragma unroll
                    for (int n = 0; n < 2; ++n) acc[a][b][m][n] = (f32x4){0.f, 0.f, 0.f, 0.f};
        cur = nxt; cA = nA; cB = nB; ++ui;
        if constexpr (ALIGN_EPI) { if (wr == 1) PG8_BAR; }
    }
    PG8_WAIT_V(0);
    if constexpr (!ALIGN_EPI) { if (wr == 0) PG8_BAR; }
    PG8_BAR;
    if constexpr (Epi::AFTER_DRAIN) { E.fused(acc, cur, wr, wc, fr, fq, lds, wid, lane); S.done(cur); }
#undef PG8_SA
#undef PG8_SB
#undef PG8_STAGE
#undef PG8_LDA
#undef PG8_LDB
#undef PG8_MMA
#undef PG8_WAIT_V
#undef PG8_WAIT_L
#undef PG8_BAR
#undef PG8_SCHED
}
}
namespace cg = cooperative_groups;
#define LAS __attribute__((address_space(3)))
typedef unsigned short bf16_t;
typedef short bf16x8 __attribute__((ext_vector_type(8)));
typedef float f32x4 __attribute__((ext_vector_type(4)));
typedef unsigned u32x4 __attribute__((ext_vector_type(4)));
typedef unsigned u32x2 __attribute__((ext_vector_type(2)));
typedef __bf16 bf16x2_n __attribute__((ext_vector_type(2)));
typedef float f32x2 __attribute__((ext_vector_type(2)));

constexpr int T = 16384, SEQ = 2048, D = 2048, FF = 5632, NGU = 2 * FF, NIN = 4608, QD = 1024, DEPTH = 2;
constexpr int ZP = FF;
constexpr float EPS = 1e-6f;
constexpr int NTHREADS = 512, NWAVES = 8;
constexpr int LDS_BYTES = 144 * 1024;
constexpr size_t SZ_GU = (size_t)NGU * D * 2, SZ_DN = (size_t)D * FF * 2, SZ_IN = (size_t)NIN * D * 2, SZ_OUT = (size_t)D * D * 2;
constexpr size_t OFF_GU1 = 0, OFF_D1 = OFF_GU1 + SZ_GU, OFF_IN = OFF_D1 + SZ_DN, OFF_OUT = OFF_IN + SZ_IN, OFF_GU2 = OFF_OUT + SZ_OUT, OFF_D2 = OFF_GU2 + SZ_GU, SZ_LAYER = OFF_D2 + SZ_DN;
constexpr size_t WS_W = 0, WS_XN = WS_W + DEPTH * SZ_LAYER, WS_BIG = WS_XN + (size_t)T * D * 2, WS_HF = WS_BIG + (size_t)T * FF * 2, WS_CTL = WS_HF + (size_t)T * D * 4, WS_LSE = WS_CTL + 32768, WS_RS = WS_LSE + (size_t)3 * T * 8 * 4, WS_LO = WS_RS + (size_t)T * 4, WS_END = WS_LO + (size_t)T * D * 2;
constexpr size_t OB_STRIDE = (size_t)T * QD;
constexpr size_t LSE_OFF = 3 * OB_STRIDE * 2;

struct Params { const float* in[16]; float* out; unsigned char* ws; };

__device__ __forceinline__ float wave_sum(float v) {
#pragma unroll
    for (int o = 1; o < 64; o <<= 1) v += __shfl_xor(v, o);
    return v;
}
__device__ __forceinline__ unsigned pk2(float lo, float hi) {
    const bf16x2_n r = __builtin_convertvector((f32x2){lo, hi}, bf16x2_n);
    return __builtin_bit_cast(unsigned, r);
}
__device__ __forceinline__ float bflo(unsigned w) { return __uint_as_float(w << 16); }
__device__ __forceinline__ float bfhi(unsigned w) { return __uint_as_float(w & 0xffff0000u); }
__device__ __forceinline__ float dot4(f32x4 a) { return (a.x * a.x + a.y * a.y) + (a.z * a.z + a.w * a.w); }

__device__ __forceinline__ void transpose_item(const float* W, int K, int N, bf16_t* WT, bool gu, LAS unsigned* scr, int item, int lane) {
    const int nblk = N / 64, kb = item / nblk, nb = item - kb * nblk, k0 = 64 * kb, n0 = 64 * nb;
    const int n4 = lane & 15, kq = lane >> 4;
    const float* src = W + (size_t)(k0 + 2 * kq) * N + n0 + 4 * n4;
    f32x4 L0[8], L1[8];
#pragma unroll
    for (int i = 0; i < 8; ++i) { L0[i] = *(const f32x4*)(src + (size_t)(8 * i) * N); L1[i] = *(const f32x4*)(src + (size_t)(8 * i + 1) * N); }
#pragma unroll
    for (int i = 0; i < 8; ++i) { const int kp = 4 * i + kq;
#pragma unroll
        for (int j = 0; j < 4; ++j) scr[(4 * n4 + j) * 33 + kp] = pk2(L0[i][j], L1[i][j]); }
    asm volatile("s_waitcnt lgkmcnt(0)" ::: "memory");
    int row0 = n0;
    if (gu) { const int up = n0 >= FF, nn = up ? n0 - FF : n0; row0 = 256 * (nn >> 7) + (up ? 128 : 0) + (nn & 127); }
    const int c = lane & 7;
#pragma unroll
    for (int j = 0; j < 8; ++j) { const int n = (lane >> 3) + 8 * j; const LAS unsigned* s = scr + n * 33 + 4 * c;
        u32x4 o; o.x = s[0]; o.y = s[1]; o.z = s[2]; o.w = s[3];
        *(u32x4*)(WT + (size_t)(row0 + n) * K + k0 + 8 * c) = o; }
    asm volatile("s_waitcnt lgkmcnt(0)" ::: "memory");
}
constexpr int IT_GU = (D / 64) * (NGU / 64), IT_DN = (FF / 64) * (D / 64), IT_IN = (D / 64) * (NIN / 64), IT_OUT = (D / 64) * (D / 64);
constexpr int IT_LAYER = 2 * IT_GU + 2 * IT_DN + IT_IN + IT_OUT;

__device__ __forceinline__ void prologue_phase(const Params& p, LAS unsigned char* lds, int gw, int ngw, int wave, int lane) {
    LAS unsigned* scr = (LAS unsigned*)(lds + wave * 16384);
    unsigned char* wsw = p.ws + WS_W;
    for (int it = gw; it < DEPTH * IT_LAYER; it += ngw) {
        const int l = it / IT_LAYER; int r = it - l * IT_LAYER;
        unsigned char* wl = wsw + (size_t)l * SZ_LAYER;
        if (r < IT_GU) { transpose_item(p.in[2] + (size_t)l * D * NGU, D, NGU, (bf16_t*)(wl + OFF_GU1), true, scr, r, lane); continue; } r -= IT_GU;
        if (r < IT_DN) { transpose_item(p.in[3] + (size_t)l * FF * D, FF, D, (bf16_t*)(wl + OFF_D1), false, scr, r, lane); continue; } r -= IT_DN;
        if (r < IT_IN) { transpose_item(p.in[6] + (size_t)l * D * NIN, D, NIN, (bf16_t*)(wl + OFF_IN), false, scr, r, lane); continue; } r -= IT_IN;
        if (r < IT_OUT) { transpose_item(p.in[10] + (size_t)l * D * D, D, D, (bf16_t*)(wl + OFF_OUT), false, scr, r, lane); continue; } r -= IT_OUT;
        if (r < IT_GU) { transpose_item(p.in[13] + (size_t)l * D * NGU, D, NGU, (bf16_t*)(wl + OFF_GU2), true, scr, r, lane); continue; } r -= IT_GU;
        transpose_item(p.in[14] + (size_t)l * FF * D, FF, D, (bf16_t*)(wl + OFF_D2), false, scr, r, lane);
    }
    const float* x = p.in[0]; const f32x4* g4 = (const f32x4*)p.in[1]; bf16_t* XN = (bf16_t*)(p.ws + WS_XN);
    for (int row = gw; row < T; row += ngw) {
        const f32x4* xr = (const f32x4*)(x + (size_t)row * D) + lane; f32x4 v[8]; float ss = 0.f;
#pragma unroll
        for (int j = 0; j < 8; ++j) { v[j] = xr[64 * j]; ss += dot4(v[j]); }
        const float rs = rsqrtf(wave_sum(ss) * (1.f / D) + EPS);
        u32x2* o = (u32x2*)(XN + (size_t)row * D) + lane;
#pragma unroll
        for (int j = 0; j < 8; ++j) { const f32x4 y = v[j] * rs * g4[lane + 64 * j]; o[64 * j] = (u32x2){pk2(y.x, y.y), pk2(y.z, y.w)}; }
    }
}

__device__ __forceinline__ f32x4 bf4lo(u32x4 w) { return (f32x4){bflo(w.x), bfhi(w.x), bflo(w.y), bfhi(w.y)}; }
__device__ __forceinline__ f32x4 bf4hi(u32x4 w) { return (f32x4){bflo(w.z), bfhi(w.z), bflo(w.w), bfhi(w.w)}; }
__device__ __forceinline__ f32x4 rcp4(f32x4 g) { return (f32x4){__builtin_amdgcn_rcpf(g.x), __builtin_amdgcn_rcpf(g.y), __builtin_amdgcn_rcpf(g.z), __builtin_amdgcn_rcpf(g.w)}; }
__device__ __forceinline__ void normres_phase(const bf16_t* hf, const float* xsrc, const float* gprev, bf16_t* HI, bf16_t* LO, float* RS, float* xdst, const float* gpost, float w, const float* gpre,
                                              int row0, int rstride, int nrows, unsigned* ctr, int poolbase, int npool, int lane) {
    const int nstat = (nrows + 1) >> 1; unsigned vnext = 0u;
    for (int trip = 0; ; ++trip) {
        int row, rowb; bool two;
        if (trip < nstat) {
            row = row0 + 2 * trip * rstride; if (row >= T) break;
            two = (2 * trip + 1 < nrows) && (row + rstride < T); rowb = two ? row + rstride : row;
            if (ctr != nullptr && trip == nstat - 1 && lane == 0) vnext = __hip_atomic_fetch_add(ctr, 1u, __ATOMIC_RELAXED, __HIP_MEMORY_SCOPE_AGENT);
        } else {
            if (ctr == nullptr) break;
            const unsigned pcur = (unsigned)__builtin_amdgcn_readfirstlane((int)vnext); if (pcur >= (unsigned)npool) break;
            row = poolbase + 2 * (int)pcur; rowb = row + 1; two = true;
            if (lane == 0) vnext = __hip_atomic_fetch_add(ctr, 1u, __ATOMIC_RELAXED, __HIP_MEMORY_SCOPE_AGENT);
        }
        u32x4 hw[2][4]; f32x4 xv[2][8];
        if (xsrc) {
#pragma unroll
            for (int q = 0; q < 2; ++q) { const int rr = q ? rowb : row;
                const u32x4* hr = (const u32x4*)(hf + (size_t)rr * D) + lane; const f32x4* xr = (const f32x4*)(xsrc + (size_t)rr * D) + 2 * lane;
#pragma unroll
                for (int c = 0; c < 4; ++c) { hw[q][c] = hr[64 * c]; xv[q][2 * c] = xr[128 * c]; xv[q][2 * c + 1] = xr[128 * c + 1]; } }
        } else {
            u32x4 hiw[2][4]; float rsp[2];
#pragma unroll
            for (int q = 0; q < 2; ++q) { const int rr = q ? rowb : row;
                const u32x4* hr = (const u32x4*)(hf + (size_t)rr * D) + lane; const u32x4* ar = (const u32x4*)(HI + (size_t)rr * D) + lane;
                rsp[q] = RS[rr];
#pragma unroll
                for (int c = 0; c < 4; ++c) { hw[q][c] = hr[64 * c]; hiw[q][c] = ar[64 * c]; } }
            const f32x4* gv4 = (const f32x4*)gprev + 2 * lane;
#pragma unroll
            for (int c = 0; c < 4; ++c) { const f32x4 ig0 = rcp4(gv4[128 * c]), ig1 = rcp4(gv4[128 * c + 1]);
#pragma unroll
                for (int q = 0; q < 2; ++q) { const float inv = __builtin_amdgcn_rcpf(rsp[q]);
                    xv[q][2 * c] = bf4lo(hiw[q][c]) * ig0 * inv; xv[q][2 * c + 1] = bf4hi(hiw[q][c]) * ig1 * inv; } }
        }
#pragma unroll
        for (int q = 0; q < 2; ++q) { if (q == 1 && !two) break; const int rr = q ? rowb : row;
            float ss = 0.f;
#pragma unroll
            for (int c = 0; c < 4; ++c) ss += dot4(bf4lo(hw[q][c])) + dot4(bf4hi(hw[q][c]));
            const float rs = rsqrtf(wave_sum(ss) * (1.f / D) + EPS) * w; float ss2 = 0.f;
            const f32x4* gp4 = (const f32x4*)gpost + 2 * lane;
#pragma unroll
            for (int c = 0; c < 4; ++c) { xv[q][2 * c] = xv[q][2 * c] + bf4lo(hw[q][c]) * rs * gp4[128 * c]; xv[q][2 * c + 1] = xv[q][2 * c + 1] + bf4hi(hw[q][c]) * rs * gp4[128 * c + 1];
                ss2 += dot4(xv[q][2 * c]) + dot4(xv[q][2 * c + 1]); }
            if (xdst) {
                f32x4* xo = (f32x4*)(xdst + (size_t)rr * D) + 2 * lane;
#pragma unroll
                for (int c = 0; c < 4; ++c) { xo[128 * c] = xv[q][2 * c]; xo[128 * c + 1] = xv[q][2 * c + 1]; }
            } else {
                const float rs2 = rsqrtf(wave_sum(ss2) * (1.f / D) + EPS);
                const f32x4* gn4 = (const f32x4*)gpre + 2 * lane; u32x4* oh = (u32x4*)(HI + (size_t)rr * D) + lane;
#pragma unroll
                for (int c = 0; c < 4; ++c) { const f32x4 y0 = xv[q][2 * c] * rs2 * gn4[128 * c], y1 = xv[q][2 * c + 1] * rs2 * gn4[128 * c + 1];
                    oh[64 * c] = (u32x4){pk2(y0.x, y0.y), pk2(y0.z, y0.w), pk2(y1.x, y1.y), pk2(y1.z, y1.w)}; }
                if (lane == 0) RS[rr] = rs2;
            }
        }
    }
}

constexpr int KS_STRIDE = 272, VT_STRIDE = 528, VT_OFF = 256 * KS_STRIDE;
static_assert(VT_OFF + 128 * VT_STRIDE <= LDS_BYTES, "attention LDS");
#define MFMA16(a, b, c) __builtin_amdgcn_mfma_f32_16x16x32_bf16((a), (b), (c), 0, 0, 0)
__device__ __forceinline__ void attn_phase(LAS unsigned char* lds, bf16_t* Z, bf16_t* OB12, float* LSE, int it0, int sA, int sB, int nit, int tid) {
    const int wid = __builtin_amdgcn_readfirstlane(tid >> 6), lane = tid & 63, l15 = lane & 15, quad = lane >> 4;
    for (int ki = 0; ki < nit; ++ki) {
        const int it = it0 + (ki & 1) * sA + (ki >> 1) * sB; if (it >= 768) break;
        const int sub = it & 15, br = (it >> 4) % 3, bg = it / 48, g = bg & 1, b = bg >> 1;
        int d, n, e; if (br == 0) { d = 1; n = sub; e = 0; } else if (br == 1) { d = 4; n = sub >> 2; e = sub & 3; } else { d = 16; n = 0; e = sub; }
        __syncthreads();
        {
            const int kp = tid >> 2, qtr = tid & 3, kj0 = 2 * kp;
            const bool valid = (n > 0) || (kj0 >= 128);
            u32x4 k0[4], k1[4], v0[4], v1[4];
            if (valid) {
                const int p0 = ((n - 1) * 128 + kj0) * d + e;
                const bf16_t* r0 = Z + (size_t)(b * SEQ + p0) * ZP + g * 128 + qtr * 32; const bf16_t* r1 = r0 + (size_t)d * ZP;
#pragma unroll
                for (int i = 0; i < 4; ++i) { k0[i] = *(const u32x4*)(r0 + 1024 + 8 * i); k1[i] = *(const u32x4*)(r1 + 1024 + 8 * i); v0[i] = *(const u32x4*)(r0 + 1280 + 8 * i); v1[i] = *(const u32x4*)(r1 + 1280 + 8 * i); }
            } else {
#pragma unroll
                for (int i = 0; i < 4; ++i) { k0[i] = (u32x4){0u, 0u, 0u, 0u}; k1[i] = k0[i]; v0[i] = k0[i]; v1[i] = k0[i]; }
            }
#pragma unroll
            for (int i = 0; i < 4; ++i) {
                *(LAS u32x4*)(lds + kj0 * KS_STRIDE + (qtr * 32 + 8 * i) * 2) = k0[i];
                *(LAS u32x4*)(lds + (kj0 + 1) * KS_STRIDE + (qtr * 32 + 8 * i) * 2) = k1[i];
#pragma unroll
                for (int w = 0; w < 4; ++w) { const unsigned a = v0[i][w], c = v1[i][w]; const int hd = qtr * 32 + 8 * i + 2 * w;
                    *(LAS unsigned*)(lds + VT_OFF + hd * VT_STRIDE + kj0 * 2) = (a & 0xffffu) | (c << 16);
                    *(LAS unsigned*)(lds + VT_OFF + (hd + 1) * VT_STRIDE + kj0 * 2) = (a >> 16) | (c & 0xffff0000u); }
            }
        }
        __syncthreads();
#pragma unroll 1
        for (int pass = 0; pass < 2; ++pass) {
            const int task = wid + 8 * pass, r = task & 3, c = task >> 2, head = g * 4 + r;
            const int kt0 = (n == 0) ? (8 - 2 * c) : 0;
            bf16x8 qf[2][4];
#pragma unroll
            for (int qt = 0; qt < 2; ++qt) { const int i = 32 * c + 16 * qt + l15; const size_t tok = (size_t)b * SEQ + (size_t)((n * 128 + i) * d + e);
                const bf16_t* qr = Z + tok * ZP + head * 128 + quad * 8;
#pragma unroll
                for (int ks = 0; ks < 4; ++ks) qf[qt][ks] = *(const bf16x8*)(qr + ks * 32); }
            f32x4 sacc[10][2];
#pragma unroll
            for (int kt = 0; kt < 10; ++kt) { sacc[kt][0] = (f32x4){0.f, 0.f, 0.f, 0.f}; sacc[kt][1] = sacc[kt][0]; }
#pragma unroll
            for (int kt = 0; kt < 10; ++kt) if (kt >= kt0) {
#pragma unroll
                for (int ks = 0; ks < 4; ++ks) { const bf16x8 kf = *(const LAS bf16x8*)(lds + (32 * c + 16 * kt + l15) * KS_STRIDE + (ks * 32 + quad * 8) * 2);
                    if (kt != 9) sacc[kt][0] = MFMA16(kf, qf[0][ks], sacc[kt][0]);
                    if (kt != 0) sacc[kt][1] = MFMA16(kf, qf[1][ks], sacc[kt][1]); }
            }
            const float SC = 0.08838834764831845f * 1.4426950408889634f;
            float mrow[2], lrow[2];
#pragma unroll
            for (int qt = 0; qt < 2; ++qt) { float mx = -__builtin_inff();
#pragma unroll
                for (int kt = 0; kt < 10; ++kt) { const int dd = kt - qt; const bool dead = (kt < kt0);
#pragma unroll
                    for (int j = 0; j < 4; ++j) { float s;
                        if (dd >= 1 && dd <= 7) s = sacc[kt][qt][j] * SC;
                        else if (dd == 0) s = (4 * quad + j >= l15) ? sacc[kt][qt][j] * SC : -__builtin_inff();
                        else if (dd == 8) s = (4 * quad + j <= l15) ? sacc[kt][qt][j] * SC : -__builtin_inff();
                        else s = -__builtin_inff();
                        if (dead) s = -__builtin_inff();
                        sacc[kt][qt][j] = s; mx = fmaxf(mx, s); } }
                mx = fmaxf(mx, __shfl_xor(mx, 16)); mx = fmaxf(mx, __shfl_xor(mx, 32));
                float l = 0.f;
#pragma unroll
                for (int kt = 0; kt < 10; ++kt) { const int dd = kt - qt;
#pragma unroll
                    for (int j = 0; j < 4; ++j) { const float pv = (dd < 0 || dd > 8) ? 0.f : __builtin_amdgcn_exp2f(sacc[kt][qt][j] - mx); sacc[kt][qt][j] = pv; l += pv; } }
                l += __shfl_xor(l, 16); l += __shfl_xor(l, 32);
                mrow[qt] = mx; lrow[qt] = l; }
            bf16x8 pf[5][2];
#pragma unroll
            for (int kp = 0; kp < 5; ++kp)
#pragma unroll
                for (int qt = 0; qt < 2; ++qt) { const f32x4 a = sacc[2 * kp][qt], c2 = sacc[2 * kp + 1][qt];
                    const u32x4 w = (u32x4){pk2(a[0], a[1]), pk2(a[2], a[3]), pk2(c2[0], c2[1]), pk2(c2[2], c2[3])}; pf[kp][qt] = __builtin_bit_cast(bf16x8, w); }
            f32x4 oacc[8][2];
#pragma unroll
            for (int ht = 0; ht < 8; ++ht) { oacc[ht][0] = (f32x4){0.f, 0.f, 0.f, 0.f}; oacc[ht][1] = oacc[ht][0]; }
#pragma unroll
            for (int kp = 0; kp < 5; ++kp) if (2 * kp >= kt0) {
#pragma unroll
                for (int ht = 0; ht < 8; ++ht) { const LAS unsigned char* vp = lds + VT_OFF + (16 * ht + l15) * VT_STRIDE + (32 * c + 32 * kp + 4 * quad) * 2;
                    const u32x2 lo = *(const LAS u32x2*)vp, hi = *(const LAS u32x2*)(vp + 32);
                    const bf16x8 vf = __builtin_bit_cast(bf16x8, ((u32x4){lo.x, lo.y, hi.x, hi.y}));
                    oacc[ht][0] = MFMA16(vf, pf[kp][0], oacc[ht][0]); oacc[ht][1] = MFMA16(vf, pf[kp][1], oacc[ht][1]); }
            }
#pragma unroll
            for (int qt = 0; qt < 2; ++qt) { const int i = 32 * c + 16 * qt + l15; const size_t tok = (size_t)b * SEQ + (size_t)((n * 128 + i) * d + e);
                const float inv = 1.0f / lrow[qt];
                bf16_t* op = (br == 0 ? Z + tok * ZP + NIN : OB12 + (size_t)b * SEQ * D + (size_t)(br - 1) * SEQ * QD + (tok - (size_t)b * SEQ) * QD) + head * 128 + 4 * quad;
#pragma unroll
                for (int ht = 0; ht < 8; ++ht) { const f32x4 o = oacc[ht][qt] * inv; *(u32x2*)(op + 16 * ht) = (u32x2){pk2(o.x, o.y), pk2(o.z, o.w)}; }
                if (quad == 0) LSE[((size_t)br * T + tok) * 8 + head] = mrow[qt] * 0.6931471805599453f + __logf(lrow[qt]); }
        }
    }
}

__device__ __forceinline__ void combine_phase(const bf16_t* Z, const bf16_t* OB12, const float* LSE, const float* convw, const float* ga, const float* gc, bf16_t* XN, int boff, int row0, int rstride, int nrows, int lane) {
    for (int kr = 0, t = row0; kr < nrows && t < T; ++kr, t += rstride) {
        const int s = t & (SEQ - 1);
        float av[2][8], cv[2][8]; float ssa = 0.f, ssc = 0.f;
#pragma unroll
        for (int j = 0; j < 2; ++j) { const int chunk = lane + 64 * j, col = chunk * 8, head = chunk >> 4;
            const float l0 = LSE[((size_t)0 * T + t) * 8 + head], l1 = LSE[((size_t)1 * T + t) * 8 + head], l2 = LSE[((size_t)2 * T + t) * 8 + head];
            const float mx = fmaxf(l0, fmaxf(l1, l2)); float w0 = __expf(l0 - mx), w1 = __expf(l1 - mx), w2 = __expf(l2 - mx); const float inv = 1.0f / (w0 + w1 + w2); w0 *= inv; w1 *= inv; w2 *= inv;
            const u32x4 o0 = *(const u32x4*)(Z + (size_t)t * ZP + NIN + col), o1 = *(const u32x4*)(OB12 + (size_t)(t >> 11) * SEQ * D + (size_t)s * QD + col), o2 = *(const u32x4*)(OB12 + (size_t)(t >> 11) * SEQ * D + (size_t)SEQ * QD + (size_t)s * QD + col);
#pragma unroll
            for (int w = 0; w < 4; ++w) { const float a0 = w0 * bflo(o0[w]) + w1 * bflo(o1[w]) + w2 * bflo(o2[w]), a1 = w0 * bfhi(o0[w]) + w1 * bfhi(o1[w]) + w2 * bfhi(o2[w]);
                av[j][2 * w] = a0; av[j][2 * w + 1] = a1; ssa += a0 * a0 + a1 * a1; } }
#pragma unroll
        for (int j = 0; j < 2; ++j) { const int ch = (lane + 64 * j) * 8; const bf16_t* zr = Z + (size_t)t * ZP;
            const u32x4 hc0 = *(const u32x4*)(zr + 1536 + ch), bg0 = *(const u32x4*)(zr + 2560 + ch), cg0 = *(const u32x4*)(zr + 3584 + ch);
            u32x4 hc1 = (u32x4){0u, 0u, 0u, 0u}, cg1 = hc1, hc2 = hc1, cg2 = hc1;
            if (s >= 1) { hc1 = *(const u32x4*)(zr - ZP + 1536 + ch); cg1 = *(const u32x4*)(zr - ZP + 3584 + ch); }
            if (s >= 2) { hc2 = *(const u32x4*)(zr - 2 * ZP + 1536 + ch); cg2 = *(const u32x4*)(zr - 2 * ZP + 3584 + ch); }
            float wk[3][8];
#pragma unroll
            for (int k = 0; k < 3; ++k) { const f32x4 a = *(const f32x4*)(convw + k * QD + ch), b2 = *(const f32x4*)(convw + k * QD + ch + 4);
                wk[k][0] = a.x; wk[k][1] = a.y; wk[k][2] = a.z; wk[k][3] = a.w; wk[k][4] = b2.x; wk[k][5] = b2.y; wk[k][6] = b2.z; wk[k][7] = b2.w; }
#pragma unroll
            for (int w = 0; w < 4; ++w) {
                const float y0 = wk[2][2 * w] * (bflo(cg0[w]) * bflo(hc0[w])) + wk[1][2 * w] * (bflo(cg1[w]) * bflo(hc1[w])) + wk[0][2 * w] * (bflo(cg2[w]) * bflo(hc2[w]));
                const float y1 = wk[2][2 * w + 1] * (bfhi(cg0[w]) * bfhi(hc0[w])) + wk[1][2 * w + 1] * (bfhi(cg1[w]) * bfhi(hc1[w])) + wk[0][2 * w + 1] * (bfhi(cg2[w]) * bfhi(hc2[w]));
                const float c0 = bflo(bg0[w]) * y0, c1 = bfhi(bg0[w]) * y1; cv[j][2 * w] = c0; cv[j][2 * w + 1] = c1; ssc += c0 * c0 + c1 * c1; } }
        const float ra = rsqrtf(wave_sum(ssa) * (1.f / QD) + EPS), rc = rsqrtf(wave_sum(ssc) * (1.f / QD) + EPS);
#pragma unroll
        for (int j = 0; j < 2; ++j) { const int col = (lane + 64 * j) * 8;
            const f32x4 g0 = *(const f32x4*)(ga + col), g1 = *(const f32x4*)(ga + col + 4), h0 = *(const f32x4*)(gc + col), h1 = *(const f32x4*)(gc + col + 4);
            u32x4 oa, oc;
            oa.x = pk2(av[j][0] * ra * g0.x, av[j][1] * ra * g0.y); oa.y = pk2(av[j][2] * ra * g0.z, av[j][3] * ra * g0.w); oa.z = pk2(av[j][4] * ra * g1.x, av[j][5] * ra * g1.y); oa.w = pk2(av[j][6] * ra * g1.z, av[j][7] * ra * g1.w);
            oc.x = pk2(cv[j][0] * rc * h0.x, cv[j][1] * rc * h0.y); oc.y = pk2(cv[j][2] * rc * h0.z, cv[j][3] * rc * h0.w); oc.z = pk2(cv[j][4] * rc * h1.x, cv[j][5] * rc * h1.y); oc.w = pk2(cv[j][6] * rc * h1.z, cv[j][7] * rc * h1.w);
            bf16_t* xo = XN + (size_t)t * D + (size_t)(t >> 11) * boff;
            *(u32x4*)(xo + col) = oa; *(u32x4*)(xo + QD + col) = oc; }
    }
}

#define XB_TMO      128
#define XB_XCNT(j)  (256  + 64 * (j))
#define XB_XSUB(j)  (1280 + 64 * (j))
#define XB_XGEN(j)  (2304 + 64 * (j))
#define XB_TOP      3328
#define XB_TOPGEN   3392
#define XCD_BAR_WORDS 3456
#define XB_SPIN_CAP (1u << 18)
__device__ __forceinline__ unsigned xb_ld(unsigned* p)              { return __hip_atomic_load(p, __ATOMIC_RELAXED, __HIP_MEMORY_SCOPE_AGENT); }
__device__ __forceinline__ unsigned xb_add(unsigned* p, unsigned v) { return __hip_atomic_fetch_add(p, v, __ATOMIC_RELAXED, __HIP_MEMORY_SCOPE_AGENT); }
__device__ __forceinline__ unsigned xb_xcc_id() { return (unsigned)__builtin_amdgcn_s_getreg((3 << 11) | 20) & 0xFu; }
#define XB_SPIN(cond, bar) do { unsigned _sp = 0; while (cond) { __builtin_amdgcn_s_sleep(1); \
    if ((++_sp & 255u) == 0u) { if (xb_ld(&(bar)[XB_TMO])) break; if (_sp > XB_SPIN_CAP) { atomicAdd(&(bar)[XB_TMO], 1u); break; } } } } while (0)
__device__ __forceinline__ void xcd_barrier_complete(unsigned* bar, unsigned x, unsigned& nloc, unsigned& nx) {
    const unsigned G = gridDim.x * gridDim.y * gridDim.z;
    unsigned sum, cnt, mine, sp = 0u;
    for (;;) {
        sum = 0u; cnt = 0u; mine = 0u;
#pragma unroll
        for (unsigned j = 0; j < 16; ++j) { const unsigned c = xb_ld(&bar[XB_XCNT(j)]); sum += c; cnt += (c > 0u) ? 1u : 0u; mine = (j == x) ? c : mine; }
        if (sum == G) break;
        __builtin_amdgcn_s_sleep(1);
        if ((++sp & 255u) == 0u) { if (xb_ld(&bar[XB_TMO])) break; if (sp > XB_SPIN_CAP) { atomicAdd(&bar[XB_TMO], 1u); break; } }
    }
    nloc = mine > 0u ? mine : 1u; nx = cnt > 0u ? cnt : 1u;
}
__device__ __forceinline__ void xcd_barrier(unsigned* bar, volatile LAS unsigned* st, int tid) {
    asm volatile("s_waitcnt vmcnt(0)" ::: "memory");
    __syncthreads();
    if (tid == 0) {
        const unsigned x = xb_xcc_id();
        __builtin_amdgcn_s_waitcnt(0);
        unsigned nloc = st[0], nx = st[1];
        if (nloc == 0u) { xcd_barrier_complete(bar, x, nloc, nx); st[0] = nloc; st[1] = nx; }
        const unsigned old = xb_add(&bar[XB_XSUB(x)], 1u);
        const unsigned gen = old / nloc;
        if (old + 1u == (gen + 1u) * nloc) {
            __builtin_amdgcn_fence(__ATOMIC_RELEASE, "agent");
            asm volatile("s_waitcnt vmcnt(0)" ::: "memory");
            const unsigned og = xb_add(&bar[XB_TOP], 1u);
            const unsigned tg = og / nx;
            if (og + 1u == (tg + 1u) * nx) xb_add(&bar[XB_TOPGEN], 1u);
            else XB_SPIN(xb_ld(&bar[XB_TOPGEN]) == tg, bar);
            __builtin_amdgcn_fence(__ATOMIC_ACQUIRE, "agent");
            xb_add(&bar[XB_XGEN(x)], 1u);
            asm volatile("s_waitcnt vmcnt(0)" ::: "memory");
        } else {
            XB_SPIN(xb_ld(&bar[XB_XGEN(x)]) == gen, bar);
            __builtin_amdgcn_fence(__ATOMIC_ACQUIRE, "agent");
            asm volatile("s_waitcnt vmcnt(0)" ::: "memory");
        }
    }
    __syncthreads();
}
#define XL_WORD(x) (4096 + 64 * (x))
__device__ __forceinline__ void xcc_local_barrier(unsigned* cnt, unsigned target, int tid) {
    asm volatile("s_waitcnt vmcnt(0)" ::: "memory");
    __syncthreads();
    if (tid == 0) {
        __builtin_amdgcn_s_waitcnt(0);
        (void)xb_add(cnt, 1u);
        unsigned sp = 0u;
        while (xb_ld(cnt) < target) { __builtin_amdgcn_s_sleep(1); if (++sp > (1u << 24)) break; }
        __builtin_amdgcn_fence(__ATOMIC_ACQUIRE, "agent");
        asm volatile("s_waitcnt vmcnt(0)" ::: "memory");
    }
    __syncthreads();
}
struct Ctx { int tid, lane, wave, G, bid, gw, ngw; };
__device__ __forceinline__ int make_tid(int wave_s) {
    int ln; asm volatile("v_mbcnt_lo_u32_b32 %0, -1, 0\n\tv_mbcnt_hi_u32_b32 %0, -1, %0" : "=&v"(ln));
    return wave_s * 64 + ln;
}
__device__ __forceinline__ Ctx make_ctx(int wave_s) {
    const int t = make_tid(wave_s);
    Ctx c; c.tid = t; c.lane = t & 63; c.wave = wave_s; c.G = gridDim.x; c.bid = blockIdx.x; c.gw = c.bid * NWAVES + c.wave; c.ngw = c.G * NWAVES; return c;
}
__device__ __forceinline__ const Params* get_params() {
    const Params* pp = (const Params*)__builtin_amdgcn_kernarg_segment_ptr(); asm volatile("" : "+s"(pp)); return pp;
}
__global__ void __launch_bounds__(NTHREADS) fwd_megakernel(Params p_unused) {
    extern __shared__ __attribute__((aligned(16))) unsigned char lds_raw[];
    LAS unsigned char* lds = (LAS unsigned char*)lds_raw;
    cg::grid_group grid = cg::this_grid();
    const int wave_s = __builtin_amdgcn_readfirstlane((int)threadIdx.x >> 6);
    volatile LAS unsigned* xst = (volatile LAS unsigned*)(lds + LDS_BYTES - 16);
    { unsigned* barp = (unsigned*)(get_params()->ws + WS_CTL); const unsigned xcc = xb_xcc_id();
      if (threadIdx.x == 0) { xst[0] = 0u; xst[1] = 0u; xst[2] = xb_add(&barp[XB_XCNT(xcc)], 1u); } }
    { const Params* pp = get_params(); const Ctx c = make_ctx(wave_s); prologue_phase(*pp, lds, c.gw, c.ngw, c.wave, c.lane); }
    __syncthreads();
    if (gridDim.y == 0x7fffu) grid.sync();
    xcd_barrier((unsigned*)(get_params()->ws + WS_CTL), xst, make_tid(wave_s));
    { unsigned* barp = (unsigned*)(get_params()->ws + WS_CTL);
      if (threadIdx.x == 0) { bool even = (gridDim.x == 256);
          for (unsigned j = 0; j < 16; ++j) { const unsigned cn = xb_ld(&barp[XB_XCNT(j)]); even = even && (j < 8 ? cn == 32u : cn == 0u); }
          xst[3] = even ? 1u : 0u; } }
    __syncthreads();
    const unsigned xcc_s = xb_xcc_id();
    const bool xlocal = __builtin_amdgcn_readfirstlane((int)xst[3]) != 0;
    const int vbid = xlocal ? (int)(__builtin_amdgcn_readfirstlane((int)xst[2]) * 8 + (int)xcc_s) : (int)blockIdx.x;
    const bool grouped = (gridDim.x == 256);
    const int vb_b = vbid & 7, vb_r = vbid >> 3;
    unsigned lk = 0u;
#define GRID_BAR() do { if (xlocal) { ++lk; xcc_local_barrier((unsigned*)(get_params()->ws + WS_CTL) + XL_WORD(xcc_s), 32u * lk, make_tid(wave_s)); } \
                        else xcd_barrier((unsigned*)(get_params()->ws + WS_CTL), xst, make_tid(wave_s)); } while (0)
#define ROW0(c) (grouped ? vb_b * SEQ + vb_r * 8 + (c).wave : (c).gw)
#define RSTRIDE(c) (grouped ? 256 : (c).ngw)
#define NROWS() (grouped ? 8 : T)
    unsigned nri = 0u;
#define DYN_WORD(i, b) (5120 + 16 * ((int)(i) * 8 + (b)))
#define NR_ARGS(c) ROW0(c), RSTRIDE(c), (grouped ? 6 : T), (grouped ? (unsigned*)(ws + WS_CTL) + DYN_WORD(nri, vb_b) : nullptr), vb_b * SEQ + 1536, 256, (c).lane
#pragma unroll 1
    for (int l = 0; l < DEPTH; ++l) {
#pragma unroll 1
        for (int f = 0; f < 2; ++f) {
            if (f == 1) {
#pragma unroll 1
                for (int part = 0; part < 2; ++part) {
                    { const Params* pp = get_params(); unsigned char* ws = pp->ws; const int G = gridDim.x, bid = vbid; const int n0 = part ? 2048 : 0, nsub = part ? NIN - 2048 : 2048;
                      pg8::Gemm g{(const bf16_t*)(ws + WS_XN), (const bf16_t*)(ws + WS_W + (size_t)l * SZ_LAYER + OFF_IN) + (size_t)n0 * D, T, nsub, D}; pg8::StaticOrder S; S.init(T, nsub, G, bid); pg8::EpiBf16 E{(bf16_t*)(ws + WS_BIG) + n0, ZP};
                      pg8::gemm_phase<pg8::EpiBf16, pg8::StaticOrder, true, true>(lds, g, S, E, make_tid(wave_s)); }
                    if (part == 0) GRID_BAR();
                }
                { const Params* pp = get_params(); unsigned char* ws = pp->ws; const Ctx c = make_ctx(wave_s);
                  int it0, sA, sB, nit;
                  if (grouped) { if (vb_r < 16) { it0 = vb_b * 96 + vb_r; sA = 48; sB = 0; nit = 2; } else { it0 = vb_b * 96 + 16 + (vb_r - 16); sA = 16; sB = 48; nit = 4; } }
                  else { it0 = c.bid; sA = c.G; sB = 2 * c.G; nit = (768 - c.bid + c.G - 1) / c.G; }
                  attn_phase(lds, (bf16_t*)(ws + WS_BIG), (bf16_t*)(ws + WS_HF + (size_t)T * D * 2), (float*)(ws + WS_LSE), it0, sA, sB, nit, c.tid); }
                GRID_BAR();
                { const Params* pp = get_params(); unsigned char* ws = pp->ws; const Ctx c = make_ctx(wave_s);
                  combine_phase((const bf16_t*)(ws + WS_BIG), (const bf16_t*)(ws + WS_HF + (size_t)T * D * 2), (const float*)(ws + WS_LSE), pp->in[7] + (size_t)l * 3 * QD, pp->in[8] + (size_t)l * QD, pp->in[9] + (size_t)l * QD,
                                (bf16_t*)(ws + WS_HF), 0, ROW0(c), RSTRIDE(c), NROWS(), c.lane); }
                GRID_BAR();
                { const Params* pp = get_params(); unsigned char* ws = pp->ws; const int G = gridDim.x, bid = vbid;
                  pg8::Gemm g{(const bf16_t*)(ws + WS_HF), (const bf16_t*)(ws + WS_W + (size_t)l * SZ_LAYER + OFF_OUT), T, D, D}; pg8::StaticOrder S; S.init(T, D, G, bid); pg8::EpiBf16 E{(bf16_t*)(ws + WS_HF + (size_t)T * D * 2), D};
                  pg8::gemm_phase<pg8::EpiBf16, pg8::StaticOrder, true, true>(lds, g, S, E, make_tid(wave_s)); }
                GRID_BAR();
                { const Params* pp = get_params(); unsigned char* ws = pp->ws; const Ctx c = make_ctx(wave_s);
                  normres_phase((const bf16_t*)(ws + WS_HF + (size_t)T * D * 2), nullptr, pp->in[5] + (size_t)l * D, (bf16_t*)(ws + WS_XN), (bf16_t*)(ws + WS_LO), (float*)(ws + WS_RS), nullptr, pp->in[11] + (size_t)l * D, 1.0f, pp->in[12] + (size_t)l * D, NR_ARGS(c)); ++nri; }
                GRID_BAR();
            }
            { const Params* pp = get_params(); unsigned char* ws = pp->ws; const int G = gridDim.x, bid = vbid;
              pg8::Gemm g{(const bf16_t*)(ws + WS_XN), (const bf16_t*)(ws + WS_W + (size_t)l * SZ_LAYER + (f ? OFF_GU2 : OFF_GU1)), T, NGU, D}; pg8::StaticOrder S; S.init(T, NGU, G, bid); pg8::EpiSwiGLU E{(bf16_t*)(ws + WS_BIG), FF};
              pg8::gemm_phase<pg8::EpiSwiGLU, pg8::StaticOrder, true, true>(lds, g, S, E, make_tid(wave_s)); }
            GRID_BAR();
            { const Params* pp = get_params(); unsigned char* ws = pp->ws; const int G = gridDim.x, bid = vbid;
              pg8::Gemm g{(const bf16_t*)(ws + WS_BIG), (const bf16_t*)(ws + WS_W + (size_t)l * SZ_LAYER + (f ? OFF_D2 : OFF_D1)), T, D, FF}; pg8::StaticOrder S; S.init(T, D, G, bid); pg8::EpiBf16 E{(bf16_t*)(ws + WS_HF), D};
              pg8::gemm_phase<pg8::EpiBf16, pg8::StaticOrder, true, true>(lds, g, S, E, make_tid(wave_s)); }
            GRID_BAR();
            { const Params* pp = get_params(); unsigned char* ws = pp->ws; const Ctx c = make_ctx(wave_s);
              const float* gpost = (f ? pp->in[15] : pp->in[4]) + (size_t)l * D;
              const float* gpre = f ? (l + 1 < DEPTH ? pp->in[1] + (size_t)(l + 1) * D : nullptr) : pp->in[5] + (size_t)l * D;
              const float* gprev = (f ? pp->in[12] : pp->in[1]) + (size_t)l * D;
              const float* xsrc = (l == 0 && f == 0) ? pp->in[0] : nullptr;
              float* xdst = (l == DEPTH - 1 && f == 1) ? pp->out : nullptr;
              normres_phase((const bf16_t*)(ws + WS_HF), xsrc, gprev, (bf16_t*)(ws + WS_XN), (bf16_t*)(ws + WS_LO), (float*)(ws + WS_RS), xdst, gpost, 0.5f, gpre, NR_ARGS(c)); ++nri; }
            if (!(l == DEPTH - 1 && f == 1)) GRID_BAR();
        }
    }
}

extern "C" void kernel_launch(void* const* d_in, const int* in_sizes, int n_in, void* d_out, int out_size, void* d_ws, size_t ws_size, hipStream_t stream) {
    static int grid_blocks = 0;
    if (grid_blocks == 0) {
        if (n_in != 16 || out_size != T * D || ws_size < WS_END) { fprintf(stderr, "kernel_launch: unexpected shapes (n_in %d out %d ws %zu need %zu)\n", n_in, out_size, ws_size, (size_t)WS_END); grid_blocks = -1; return; }
        int dev = 0, cus = 0, per_cu = 0;
        hipGetDevice(&dev);
        hipDeviceGetAttribute(&cus, hipDeviceAttributeMultiprocessorCount, dev);
        if (hipFuncSetAttribute((const void*)fwd_megakernel, hipFuncAttributeMaxDynamicSharedMemorySize, LDS_BYTES) != hipSuccess) { fprintf(stderr, "kernel_launch: hipFuncSetAttribute failed\n"); }
        if (hipOccupancyMaxActiveBlocksPerMultiprocessor(&per_cu, (const void*)fwd_megakernel, NTHREADS, LDS_BYTES) != hipSuccess || per_cu < 1) { fprintf(stderr, "kernel_launch: occupancy query gave %d\n", per_cu); per_cu = 1; }
        (void)hipGetLastError();
        grid_blocks = cus * 1;
        if (grid_blocks <= 0) grid_blocks = 256;
    }
    if (grid_blocks < 0) return;
    Params p{};
    for (int i = 0; i < 16; ++i) p.in[i] = (const float*)d_in[i];
    p.out = (float*)d_out; p.ws = (unsigned char*)d_ws;
    if (hipMemsetAsync((unsigned char*)d_ws + WS_CTL, 0, 32768, stream) != hipSuccess) fprintf(stderr, "kernel_launch: memset of barrier words failed\n");
    void* args[] = {&p};
    hipError_t e = hipLaunchCooperativeKernel((const void*)fwd_megakernel, dim3(grid_blocks), dim3(NTHREADS), args, LDS_BYTES, stream);
    if (e != hipSuccess) fprintf(stderr, "cooperative launch failed: %s (grid %d)\n", hipGetErrorString(e), grid_blocks);
}
```
